# Optimizing an MI355X kernel written in HIP

```python
import math
import jax, jax.numpy as jnp
from jax import lax
import numpy as np


D_MODEL = 1024
BATCH = 2
SEQ = 8192
DEPTH = 4

CHUNK = 64
N_MIXERS = 3
Q_BLOCK = 128
EPS = 1e-6
ROPE_THETA = 10000.0
NEG = -1e30

H_A = 16
DH_A = 64
H_IDX = 8
D_IDX = 64
D_IDX_ROPE = 32
TOPK_MAX = 256
T5_BUCKETS = 32
T5_MAX_DIST = 128
A_IN = 3 * H_A * DH_A + H_IDX * D_IDX + D_IDX + H_IDX

H_B = 16
Q_LORA = 256
KV_LORA = 128
QK_NOPE = 64
QK_ROPE = 32
V_DIM = 64
B_DOWN = Q_LORA + KV_LORA + QK_ROPE

H_C = 16
DH_C = 64
LEFT_CHUNKS = 8
REL_MAX_PAST = 128
REL_SPAN = REL_MAX_PAST + CHUNK

D_FF = 2816
CONV_W = 3

N_A = (DEPTH + 2) // N_MIXERS
N_B = (DEPTH + 1) // N_MIXERS
N_C = DEPTH // N_MIXERS

kernel_name = 'hybrid_chunk_causal_dsa_mla_band_convffn'


def rms_norm(x, g):
    xf = x.astype(jnp.float32)
    y = xf * lax.rsqrt(jnp.mean(xf * xf, axis=-1, keepdims=True) + EPS)
    return (y * g.astype(jnp.float32)).astype(x.dtype)


def rope_tables(seq, dim, dtype):
    inv = 1.0 / (ROPE_THETA ** (jnp.arange(0, dim, 2, dtype=jnp.float32) / dim))
    ang = jnp.arange(seq, dtype=jnp.float32)[:, None] * inv[None, :]
    return jnp.cos(ang).astype(dtype), jnp.sin(ang).astype(dtype)


def rope_tail(x, n_rot, cos, sin):
    xp, xr = x[..., :-n_rot], x[..., -n_rot:]
    x1, x2 = jnp.split(xr, 2, axis=-1)
    rot = jnp.concatenate([x1 * cos - x2 * sin, x1 * sin + x2 * cos], axis=-1)
    return jnp.concatenate([xp, rot], axis=-1)


def t5_bucket(rel):
    nb = T5_BUCKETS // 2
    max_exact = nb // 2
    n = jnp.abs(rel)
    large = max_exact + (jnp.log(jnp.maximum(n, 1).astype(jnp.float32) / max_exact)
                         / math.log(T5_MAX_DIST / max_exact) * (nb - max_exact)).astype(jnp.int32)
    large = jnp.minimum(large, nb - 1)
    return jnp.where(rel > 0, nb, 0) + jnp.where(n < max_exact, n, large)


def chunk_limit(pos):
    return (pos // CHUNK + 1) * CHUNK


def mixer_a(h, w_in, q_g, k_g, kidx_g, w_out, t5_bias):
    B, S, _ = h.shape
    topk = min(TOPK_MAX, S // 4)
    hd = H_A * DH_A
    q, k, v, qi, ki, wi = jnp.split(
        h @ w_in, [hd, 2 * hd, 3 * hd, 3 * hd + H_IDX * D_IDX, 3 * hd + H_IDX * D_IDX + D_IDX], axis=-1)
    q = rms_norm(q.reshape(B, S, H_A, DH_A), q_g)
    k = rms_norm(k.reshape(B, S, H_A, DH_A), k_g)
    v = v.reshape(B, S, H_A, DH_A)
    cos, sin = rope_tables(S, D_IDX_ROPE, h.dtype)
    qi = rope_tail(qi.reshape(B, S, H_IDX, D_IDX), D_IDX_ROPE, cos[:, None, :], sin[:, None, :])
    ki = rope_tail(rms_norm(ki, kidx_g), D_IDX_ROPE, cos, sin)
    pos = jnp.arange(S, dtype=jnp.int32)
    gather = jax.vmap(lambda arr, ib: arr[ib])

    def block(i):
        t0 = i * Q_BLOCK
        qb = lax.dynamic_slice_in_dim(q, t0, Q_BLOCK, axis=1)
        qib = lax.dynamic_slice_in_dim(qi, t0, Q_BLOCK, axis=1)
        wib = lax.dynamic_slice_in_dim(wi, t0, Q_BLOCK, axis=1)
        tq = t0 + jnp.arange(Q_BLOCK, dtype=jnp.int32)
        lim = chunk_limit(tq)
        sc = jnp.einsum('bqhd,bsd->bqhs', qib, ki).astype(jnp.float32) * (D_IDX ** -0.5)
        score = jnp.einsum('bqhs,bqh->bqs', jax.nn.relu(sc), wib.astype(jnp.float32)) * (H_IDX ** -0.5)
        score = jnp.where((pos[None, :] < lim[:, None])[None], score, -jnp.inf)
        _, idx = lax.top_k(score, topk)
        valid = idx < lim[None, :, None]
        ks = gather(k, idx)
        vs = gather(v, idx)
        logits = jnp.einsum('bqhd,bqkhd->bhqk', qb, ks).astype(jnp.float32) * (DH_A ** -0.5)
        bias = t5_bias[t5_bucket(idx - tq[None, :, None])]
        logits = logits + jnp.transpose(bias, (0, 3, 1, 2)).astype(jnp.float32)
        logits = jnp.where(valid[:, None], logits, NEG)
        p = jax.nn.softmax(logits, axis=-1).astype(vs.dtype)
        return jnp.einsum('bhqk,bqkhd->bqhd', p, vs)

    out = lax.map(block, jnp.arange(S // Q_BLOCK))
    out = jnp.transpose(out, (1, 0, 2, 3, 4)).reshape(B, S, hd)
    return out @ w_out


def mixer_b(h, w_down, qa_g, kva_g, w_uq, w_ukv, q_g, k_g, w_out):
    B, S, _ = h.shape
    cq, ckv, kr = jnp.split(h @ w_down, [Q_LORA, Q_LORA + KV_LORA], axis=-1)
    q = (rms_norm(cq, qa_g) @ w_uq).reshape(B, S, H_B, QK_NOPE + QK_ROPE)
    kv = (rms_norm(ckv, kva_g) @ w_ukv).reshape(B, S, H_B, QK_NOPE + V_DIM)
    k_nope, v = kv[..., :QK_NOPE], kv[..., QK_NOPE:]
    k = jnp.concatenate([k_nope, jnp.broadcast_to(kr[:, :, None, :], (B, S, H_B, QK_ROPE))], axis=-1)
    cos, sin = rope_tables(S, QK_ROPE, h.dtype)
    q = rope_tail(rms_norm(q, q_g), QK_ROPE, cos[:, None, :], sin[:, None, :])
    k = rope_tail(rms_norm(k, k_g), QK_ROPE, cos[:, None, :], sin[:, None, :])
    pos = jnp.arange(S, dtype=jnp.int32)
    scale = (QK_NOPE + QK_ROPE) ** -0.5

    def block(i):
        t0 = i * Q_BLOCK
        qb = lax.dynamic_slice_in_dim(q, t0, Q_BLOCK, axis=1)
        lim = chunk_limit(t0 + jnp.arange(Q_BLOCK, dtype=jnp.int32))
        logits = jnp.einsum('bqhd,bshd->bhqs', qb, k).astype(jnp.float32) * scale
        logits = jnp.where((pos[None, :] < lim[:, None])[None, None], logits, NEG)
        p = jax.nn.softmax(logits, axis=-1).astype(v.dtype)
        return jnp.einsum('bhqs,bshd->bqhd', p, v)

    out = lax.map(block, jnp.arange(S // Q_BLOCK))
    out = jnp.transpose(out, (1, 0, 2, 3, 4)).reshape(B, S, H_B * V_DIM)
    return out @ w_out


def mixer_c(h, w_in, q_g, k_g, rel_bias, w_out):
    B, S, _ = h.shape
    q, k, v = jnp.split(h @ w_in, 3, axis=-1)
    q = rms_norm(q.reshape(B, S, H_C, DH_C), q_g)
    k = rms_norm(k.reshape(B, S, H_C, DH_C), k_g)
    v = v.reshape(B, S, H_C, DH_C)
    pad = LEFT_CHUNKS * CHUNK
    band = pad + CHUNK
    kp = jnp.pad(k, ((0, 0), (pad, 0), (0, 0), (0, 0)))
    vp = jnp.pad(v, ((0, 0), (pad, 0), (0, 0), (0, 0)))
    qi = jnp.arange(CHUNK, dtype=jnp.int32)
    kj = jnp.arange(band, dtype=jnp.int32)
    dist = qi[:, None] - kj[None, :] + pad
    bias = rel_bias[:, jnp.clip(dist, -(CHUNK - 1), REL_MAX_PAST) + CHUNK - 1].astype(jnp.float32)
    scale = DH_C ** -0.5

    def chunk(c):
        t0 = c * CHUNK
        qc = lax.dynamic_slice_in_dim(q, t0, CHUNK, axis=1)
        kc = lax.dynamic_slice_in_dim(kp, t0, band, axis=1)
        vc = lax.dynamic_slice_in_dim(vp, t0, band, axis=1)
        key_ok = (t0 - pad + kj) >= 0
        logits = jnp.einsum('bqhd,bkhd->bhqk', qc, kc).astype(jnp.float32) * scale + bias
        logits = jnp.where(key_ok[None, None, None, :], logits, NEG)
        p = jax.nn.softmax(logits, axis=-1).astype(vc.dtype)
        return jnp.einsum('bhqk,bkhd->bqhd', p, vc)

    out = lax.map(chunk, jnp.arange(S // CHUNK))
    out = jnp.transpose(out, (1, 0, 2, 3, 4)).reshape(B, S, H_C * DH_C)
    return out @ w_out


def conv_ffn(h, w_up, conv_w, conv_b, w_down):
    S = h.shape[1]
    u = h @ w_up
    up = jnp.pad(u, ((0, 0), (CONV_W - 1, 0), (0, 0)))
    u = conv_b + sum(conv_w[j] * up[:, j:j + S] for j in range(CONV_W))
    gate, val = jnp.split(u, 2, axis=-1)
    return (jax.nn.silu(gate) * val) @ w_down


def setup_inputs(seed: int = 0) -> dict:
    key = jax.random.key(seed)
    ks = iter(jax.random.split(key, 32))
    f32 = jnp.float32

    def dense(shape, fan_in):
        return jax.random.normal(next(ks), shape, f32) * fan_in ** -0.5

    def gain(shape):
        return 1.0 + 0.05 * jax.random.normal(next(ks), shape, f32)

    def small(shape, s):
        return s * jax.random.normal(next(ks), shape, f32)

    return {
        'x': jax.random.normal(next(ks), (BATCH, SEQ, D_MODEL), f32),
        'norm_mix': gain((DEPTH, D_MODEL)),
        'norm_ffn': gain((DEPTH, D_MODEL)),
        't5_bias': small((T5_BUCKETS, H_A), 0.5),
        'a_w_in': dense((N_A, D_MODEL, A_IN), D_MODEL),
        'a_q_norm': gain((N_A, DH_A)),
        'a_k_norm': gain((N_A, DH_A)),
        'a_kidx_norm': gain((N_A, D_IDX)),
        'a_w_out': dense((N_A, H_A * DH_A, D_MODEL), H_A * DH_A),
        'b_w_down': dense((N_B, D_MODEL, B_DOWN), D_MODEL),
        'b_q_a_norm': gain((N_B, Q_LORA)),
        'b_kv_a_norm': gain((N_B, KV_LORA)),
        'b_w_uq': dense((N_B, Q_LORA, H_B * (QK_NOPE + QK_ROPE)), Q_LORA),
        'b_w_ukv': dense((N_B, KV_LORA, H_B * (QK_NOPE + V_DIM)), KV_LORA),
        'b_q_norm': gain((N_B, QK_NOPE + QK_ROPE)),
        'b_k_norm': gain((N_B, QK_NOPE + QK_ROPE)),
        'b_w_out': dense((N_B, H_B * V_DIM, D_MODEL), H_B * V_DIM),
        'c_w_in': dense((N_C, D_MODEL, 3 * H_C * DH_C), D_MODEL),
        'c_q_norm': gain((N_C, DH_C)),
        'c_k_norm': gain((N_C, DH_C)),
        'c_rel_bias': small((N_C, H_C, REL_SPAN), 0.5),
        'c_w_out': dense((N_C, H_C * DH_C, D_MODEL), H_C * DH_C),
        'f_w_up': dense((DEPTH, D_MODEL, 2 * D_FF), D_MODEL),
        'f_conv_w': dense((DEPTH, CONV_W, 2 * D_FF), CONV_W),
        'f_conv_b': small((DEPTH, 2 * D_FF), 0.01),
        'f_w_down': dense((DEPTH, D_FF, D_MODEL), D_FF),
    }


def reference(x, norm_mix, norm_ffn, t5_bias,
              a_w_in, a_q_norm, a_k_norm, a_kidx_norm, a_w_out,
              b_w_down, b_q_a_norm, b_kv_a_norm, b_w_uq, b_w_ukv, b_q_norm, b_k_norm, b_w_out,
              c_w_in, c_q_norm, c_k_norm, c_rel_bias, c_w_out,
              f_w_up, f_conv_w, f_conv_b, f_w_down):
    for layer in range(DEPTH):
        h = rms_norm(x, norm_mix[layer])
        kind = layer % N_MIXERS
        j = layer // N_MIXERS
        if kind == 0:
            m = mixer_a(h, a_w_in[j], a_q_norm[j], a_k_norm[j], a_kidx_norm[j], a_w_out[j], t5_bias)
        elif kind == 1:
            m = mixer_b(h, b_w_down[j], b_q_a_norm[j], b_kv_a_norm[j], b_w_uq[j], b_w_ukv[j],
                        b_q_norm[j], b_k_norm[j], b_w_out[j])
        else:
            m = mixer_c(h, c_w_in[j], c_q_norm[j], c_k_norm[j], c_rel_bias[j], c_w_out[j])
        x = x + m
        x = x + conv_ffn(rms_norm(x, norm_ffn[layer]), f_w_up[layer], f_conv_w[layer],
                         f_conv_b[layer], f_w_down[layer])
    return x
```

```cpp
#include <hip/hip_runtime.h>
#include <stdint.h>
#include <stdio.h>
#include <math.h>

constexpr int D_MODEL = 1024, BATCH = 2, SEQ = 8192, DEPTH = 4, M_TOK = BATCH * SEQ;
constexpr int CHUNK = 64;
constexpr int A_IN = 3656, A_INP = 3840, B_DOWN = 416, B_DOWNP = 512, D_FF = 2816, UPW = 2 * D_FF;
constexpr float EPS = 1e-6f;
constexpr int NWAVES = 8, NTHR = NWAVES * 64;

#define GAS __attribute__((address_space(1)))
#define LAS __attribute__((address_space(3)))
typedef unsigned short bf16_t;
typedef unsigned v4u __attribute__((ext_vector_type(4)));
typedef unsigned v2u __attribute__((ext_vector_type(2)));
typedef float v4f __attribute__((ext_vector_type(4)));
typedef GAS unsigned gu32;
#define RLX_AGENT __ATOMIC_RELAXED, __HIP_MEMORY_SCOPE_AGENT
#define LDS_WAIT() asm volatile("s_waitcnt lgkmcnt(0)" ::: "memory")

__device__ __forceinline__ float bf2f(bf16_t v) { return __uint_as_float(((unsigned)v) << 16); }
__device__ __forceinline__ float bflo(unsigned w) { return __uint_as_float(w << 16); }
__device__ __forceinline__ float bfhi(unsigned w) { return __uint_as_float(w & 0xffff0000u); }
__device__ __forceinline__ unsigned f2bfu(float f) { unsigned u = __float_as_uint(f); return (u + 0x7fffu + ((u >> 16) & 1u)) >> 16; }
__device__ __forceinline__ bf16_t f2bf(float f) { return (bf16_t)f2bfu(f); }
typedef float pk2_f32x2_t __attribute__((ext_vector_type(2))); typedef __bf16 pk2_bf16x2_t __attribute__((ext_vector_type(2)));
__device__ __forceinline__ unsigned pk2(float lo, float hi) { const pk2_f32x2_t v = {lo, hi}; const pk2_bf16x2_t b = __builtin_convertvector(v, pk2_bf16x2_t); return __builtin_bit_cast(unsigned, b); }

__device__ __forceinline__ float wave_sum(float v) {
#pragma unroll
    for (int o = 1; o < 64; o <<= 1) v += __shfl_xor(v, o);
    return v;
}

__device__ const float c_inv[16] = {1.000000000e+00f, 5.623413324e-01f, 3.162277639e-01f, 1.778279394e-01f, 1.000000015e-01f, 5.623413250e-02f, 3.162277490e-02f, 1.778279431e-02f,
                                    9.999999776e-03f, 5.623413250e-03f, 3.162277630e-03f, 1.778279431e-03f, 1.000000047e-03f, 5.623413017e-04f, 3.162277571e-04f, 1.778279402e-04f};

__device__ __forceinline__ int t5_bucket(int rel) {
    int n = rel < 0 ? -rel : rel;
    int b;
    if (n < 8) b = n;
    else if (n < 12) b = 8; else if (n < 16) b = 9; else if (n < 23) b = 10; else if (n < 32) b = 11;
    else if (n < 46) b = 12; else if (n < 64) b = 13; else if (n < 91) b = 14; else b = 15;
    return (rel > 0 ? 16 : 0) + b;
}
__device__ __forceinline__ unsigned fkey(float f) { const unsigned u = __float_as_uint(f); return (u & 0x80000000u) ? ~u : (u | 0x80000000u); }

namespace pg8 {
#define PG8_LAS __attribute__((address_space(3)))
typedef unsigned short bf16_t;
typedef short bf16x8 __attribute__((ext_vector_type(8)));
typedef float f32x4 __attribute__((ext_vector_type(4)));
typedef unsigned u32x4 __attribute__((ext_vector_type(4)));
constexpr int BM = 256, BK = 64, HALF = 128, HTB = HALF * BK * 2  , STAGE_BYTES = 8 * HTB, NXCD = 8, WGM = 8;

__host__ __device__ __forceinline__ int lds_byte(int r, int c) { const int st = (r >> 4) * 2 + (c >> 5), rr = r & 15, cc = c & 31, ob = rr * 64 + cc * 2; return st * 1024 + (ob ^ (((ob >> 9) & 1) << 5)); }
__host__ __device__ __forceinline__ void stage_rc(int b, int& R, int& C) { const int st = b / 1024, sb = b % 1024, swz = sb ^ (((sb >> 9) & 1) << 5); R = (st >> 1) * 16 + swz / 64; C = (st & 1) * 32 + (swz % 64) / 2; }
__host__ __device__ __forceinline__ int perm32(int rho) { const int n = rho >> 4, i = rho & 15; return 8 * (i >> 2) + 4 * n + (i & 3); }

struct Unit { int pm, pn; };
struct Gemm { const bf16_t* A; const bf16_t* Bt; int M, N, K; };

struct StaticOrder {
    int nM, nN, nwg, G, c;
    __host__ __device__ void init(int M, int N, int G_, int c_) { nM = M / BM; nN = N / BM; nwg = nM * nN; G = G_; c = c_; }
    __host__ __device__ bool next(int i, Unit& u) const {
        const long L = (long)i * G + c; if (L >= nwg) return false;
        int wgid = (int)L; { const int q = nwg / NXCD, r = nwg % NXCD, xcd = wgid % NXCD, off = wgid / NXCD; wgid = (xcd < r ? xcd * (q + 1) : r * (q + 1) + (xcd - r) * q) + off; }
        const int nig = WGM * nN, gid = wgid / nig, fm = gid * WGM, gsz = (nM - fm) < WGM ? (nM - fm) : WGM;
        u.pm = fm + ((wgid % nig) % gsz); u.pn = (wgid % nig) / gsz; return true;
    }
    __device__ __forceinline__ void a_ready(const Unit&) const {}
    __device__ __forceinline__ void done(const Unit&) const {}
};

struct SliceOrder { StaticOrder so; int slice;
    __host__ __device__ bool next(int i, Unit& u) const { return i == 0 ? so.next(slice, u) : false; }
    __device__ __forceinline__ void a_ready(const Unit&) const {}
    __device__ __forceinline__ void done(const Unit&) const {} };

__device__ __forceinline__ unsigned cvt_pk_bf16(float lo, float hi) { unsigned r; asm volatile("v_cvt_pk_bf16_f32 %0, %1, %2" : "=v"(r) : "v"(lo), "v"(hi)); return r; }
typedef unsigned u32x2 __attribute__((ext_vector_type(2)));
__device__ __forceinline__ void row_scales(float (&rs)[2][4], const float* ssq, int row0, int fq) {
    f32x4 q[2][4];
#pragma unroll
    for (int ai = 0; ai < 2; ++ai)
#pragma unroll
        for (int m = 0; m < 4; ++m) q[ai][m] = *(const f32x4*)(ssq + (size_t)(row0 + ai * HALF + m * 16) * 16 + 4 * fq);
#pragma unroll
    for (int ai = 0; ai < 2; ++ai)
#pragma unroll
        for (int m = 0; m < 4; ++m) { float t = (q[ai][m][0] + q[ai][m][1]) + (q[ai][m][2] + q[ai][m][3]); t += __shfl_xor(t, 16); t += __shfl_xor(t, 32);
            rs[ai][m] = 1.0f / sqrtf(t * (1.0f / 1024.0f) + 1e-6f); }
}
struct EpiStore {
    static constexpr bool PERM = true, AFTER_DRAIN = false;
    bf16_t* O; int ldc; const float* ssq;
    __device__ __forceinline__ void operator()(const f32x4 (&acc)[2][2][4][2], const Unit& u, int wr, int wc, int fr, int fq) const {
        const int row0 = u.pm * BM + wr * 64 + fr; const int col0 = u.pn * BM + wc * 32 + 8 * fq;
        float rsa[2][4];
#pragma unroll
        for (int ai = 0; ai < 2; ++ai)
#pragma unroll
            for (int m = 0; m < 4; ++m) rsa[ai][m] = 1.0f;
        if (ssq) row_scales(rsa, ssq, row0, fq);
#pragma unroll
        for (int ai = 0; ai < 2; ++ai)
#pragma unroll
            for (int m = 0; m < 4; ++m) { bf16_t* rowp = O + (size_t)(row0 + ai * HALF + m * 16) * ldc + col0;
                const float rs = rsa[ai][m];
#pragma unroll
                for (int bj = 0; bj < 2; ++bj) { const f32x4 v0 = acc[ai][bj][m][0] * rs, v1 = acc[ai][bj][m][1] * rs;
                    u32x4 w; w.x = cvt_pk_bf16(v0[0], v0[1]); w.y = cvt_pk_bf16(v0[2], v0[3]); w.z = cvt_pk_bf16(v1[0], v1[1]); w.w = cvt_pk_bf16(v1[2], v1[3]);
                    *(u32x4*)(rowp + bj * HALF) = w; } }
    }
};
struct EpiResid {
    static constexpr bool PERM = false, AFTER_DRAIN = false;
    const float* base; float* out; int ldc; bf16_t* xb; float* ssq;
    __device__ __forceinline__ void operator()(const f32x4 (&acc)[2][2][4][2], const Unit& u, int wr, int wc, int fr, int fq) const {
        const int col0 = u.pn * BM + wc * 32 + 4 * fq;
#pragma unroll
        for (int ai = 0; ai < 2; ++ai) {
            f32x4 bs[4][2][2];
#pragma unroll
            for (int m = 0; m < 4; ++m) { const size_t off = (size_t)(u.pm * BM + ai * HALF + wr * 64 + m * 16 + fr) * ldc + col0;
#pragma unroll
                for (int bj = 0; bj < 2; ++bj)
#pragma unroll
                    for (int n = 0; n < 2; ++n) bs[m][bj][n] = *(const f32x4*)(base + off + bj * HALF + n * 16); }
#pragma unroll
            for (int m = 0; m < 4; ++m) { const int row = u.pm * BM + ai * HALF + wr * 64 + m * 16 + fr; const size_t off = (size_t)row * ldc + col0; float s = 0.f;
#pragma unroll
                for (int bj = 0; bj < 2; ++bj)
#pragma unroll
                    for (int n = 0; n < 2; ++n) { const f32x4 o = bs[m][bj][n] + acc[ai][bj][m][n]; *(f32x4*)(out + off + bj * HALF + n * 16) = o;
                        if (xb) { s += (o[0] * o[0] + o[1] * o[1]) + (o[2] * o[2] + o[3] * o[3]); u32x2 w; w.x = cvt_pk_bf16(o[0], o[1]); w.y = cvt_pk_bf16(o[2], o[3]); *(u32x2*)(xb + off + bj * HALF + n * 16) = w; } }
                if (xb) { s += __shfl_xor(s, 16); s += __shfl_xor(s, 32); if (fq == 0) ssq[(size_t)row * 16 + u.pn * 4 + wc] = s; }
            }
            asm volatile("" ::: "memory");
        }
    }
};


struct EpiResidB {
    static constexpr bool PERM = false, AFTER_DRAIN = false;
    bf16_t* xb; float* ssq; float* outf; int ldc; bool wxb;
    __device__ __forceinline__ void operator()(const f32x4 (&acc)[2][2][4][2], const Unit& u, int wr, int wc, int fr, int fq) const {
        const int col0 = u.pn * BM + wc * 32 + 4 * fq;
#pragma unroll
        for (int ai = 0; ai < 2; ++ai) {
            u32x2 bs[4][2][2];
#pragma unroll
            for (int m = 0; m < 4; ++m) { const size_t off = (size_t)(u.pm * BM + ai * HALF + wr * 64 + m * 16 + fr) * ldc + col0;
#pragma unroll
                for (int bj = 0; bj < 2; ++bj)
#pragma unroll
                    for (int n = 0; n < 2; ++n) bs[m][bj][n] = *(const u32x2*)(xb + off + bj * HALF + n * 16); }
#pragma unroll
            for (int m = 0; m < 4; ++m) { const int row = u.pm * BM + ai * HALF + wr * 64 + m * 16 + fr; const size_t off = (size_t)row * ldc + col0; float s = 0.f;
#pragma unroll
                for (int bj = 0; bj < 2; ++bj)
#pragma unroll
                    for (int n = 0; n < 2; ++n) { const u32x2 b = bs[m][bj][n];
                        f32x4 o; o[0] = __uint_as_float(b.x << 16) + acc[ai][bj][m][n][0]; o[1] = __uint_as_float(b.x & 0xffff0000u) + acc[ai][bj][m][n][1];
                        o[2] = __uint_as_float(b.y << 16) + acc[ai][bj][m][n][2]; o[3] = __uint_as_float(b.y & 0xffff0000u) + acc[ai][bj][m][n][3];
                        if (outf) *(f32x4*)(outf + off + bj * HALF + n * 16) = o;
                        s += (o[0] * o[0] + o[1] * o[1]) + (o[2] * o[2] + o[3] * o[3]);
                        if (wxb) { u32x2 w; w.x = cvt_pk_bf16(o[0], o[1]); w.y = cvt_pk_bf16(o[2], o[3]); *(u32x2*)(xb + off + bj * HALF + n * 16) = w; } }
                if (ssq) { s += __shfl_xor(s, 16); s += __shfl_xor(s, 32); if (fq == 0) ssq[(size_t)row * 16 + u.pn * 4 + wc] = s; }
            }
            asm volatile("" ::: "memory");
        }
    }
};

struct EpiInAC {
    static constexpr bool PERM = true, AFTER_DRAIN = false;
    bf16_t* Q; bf16_t* K; bf16_t* V; bf16_t* SI; int ldi; int nqk; const float* ssq; const float* qg; const float* kg;
    __device__ __forceinline__ void operator()(const f32x4 (&acc)[2][2][4][2], const Unit& u, int wr, int wc, int fr, int fq) const {
        const int row0 = u.pm * BM + wr * 64 + fr;
        const int sel = u.pn / nqk;
        f32x4 ga[2][2];
        float osc = 1.0f;
        if (sel < 2) { const float* g = sel ? kg : qg;
#pragma unroll
            for (int bj = 0; bj < 2; ++bj)
#pragma unroll
                for (int n = 0; n < 2; ++n) ga[bj][n] = *(const f32x4*)(g + 32 * bj + 8 * fq + 4 * n);
            if (sel == 0) osc = 0.125f * 1.4426950408889634f; }
        float rsa[2][4]; row_scales(rsa, ssq, row0, fq);
#pragma unroll
        for (int ai = 0; ai < 2; ++ai)
#pragma unroll
            for (int m = 0; m < 4; ++m) { const int row = row0 + ai * HALF + m * 16;
                const float rs = rsa[ai][m];
                f32x4 v[2][2];
#pragma unroll
                for (int bj = 0; bj < 2; ++bj)
#pragma unroll
                    for (int n = 0; n < 2; ++n) v[bj][n] = acc[ai][bj][m][n] * rs;
                if (sel < 2) {
                    float ss = 0.f;
#pragma unroll
                    for (int bj = 0; bj < 2; ++bj)
#pragma unroll
                        for (int n = 0; n < 2; ++n) ss += (v[bj][n][0] * v[bj][n][0] + v[bj][n][1] * v[bj][n][1]) + (v[bj][n][2] * v[bj][n][2] + v[bj][n][3] * v[bj][n][3]);
                    ss += __shfl_xor(ss, 16); ss += __shfl_xor(ss, 32);
                    const float r = osc / sqrtf(ss * (1.0f / 64.0f) + 1e-6f);
                    bf16_t* rowp = (sel ? K : Q) + (size_t)row * 1024 + (u.pn - sel * nqk) * 256 + wc * 64 + 8 * fq;
#pragma unroll
                    for (int bj = 0; bj < 2; ++bj) { const f32x4 v0 = v[bj][0] * r * ga[bj][0], v1 = v[bj][1] * r * ga[bj][1];
                        u32x4 w; w.x = cvt_pk_bf16(v0[0], v0[1]); w.y = cvt_pk_bf16(v0[2], v0[3]); w.z = cvt_pk_bf16(v1[0], v1[1]); w.w = cvt_pk_bf16(v1[2], v1[3]);
                        *(u32x4*)(rowp + 32 * bj) = w; }
                } else {
                    bf16_t* rowp = sel == 2 ? (V + (size_t)row * 1024 + (u.pn - 2 * nqk) * 256) : (SI + (size_t)row * ldi + (u.pn - 3 * nqk) * 256);
                    rowp += wc * 32 + 8 * fq;
#pragma unroll
                    for (int bj = 0; bj < 2; ++bj) { const f32x4 v0 = v[bj][0], v1 = v[bj][1];
                        u32x4 w; w.x = cvt_pk_bf16(v0[0], v0[1]); w.y = cvt_pk_bf16(v0[2], v0[3]); w.z = cvt_pk_bf16(v1[0], v1[1]); w.w = cvt_pk_bf16(v1[2], v1[3]);
                        *(u32x4*)(rowp + bj * HALF) = w; }
                }
            }
    }
};
template <class Epi, class Sched, bool ALIGN_EPI = false, bool SP2 = false>
__device__ __forceinline__ void gemm_phase(PG8_LAS unsigned char* lds, const Gemm g, const Sched& S, const Epi& E) {
    const int tid = threadIdx.x, wid = __builtin_amdgcn_readfirstlane(tid >> 6), lane = tid & 63, wr = wid >> 2, wc = wid & 3, fr = lane & 15, fq = lane >> 4;
    const int K = g.K, nt = K / BK;
    unsigned voffA[2], voffB[2];
#pragma unroll
    for (int i = 0; i < 2; ++i) { int R, C; stage_rc(tid * 16 + i * 8192, R, C); const int Rb = Epi::PERM ? ((R & ~31) + perm32(R & 31)) : R;
        voffA[i] = (unsigned)(R * K + C) * 2u; voffB[i] = (unsigned)(Rb * K + C) * 2u; }
    const size_t kstep = (size_t)(BK * 2);
    const size_t hstep = (size_t)HALF * K * 2;
    const size_t tstep = 2 * hstep;
    const unsigned ldsw = (unsigned)wid * 1024u;
    const int aoff = lds_byte(wr * 64 + fr, fq * 8), boff = lds_byte(wc * 32 + fr, fq * 8);
#define PG8_SA(b, h) (((b) * 2 + (h)) * HTB)
#define PG8_SB(b, h) ((4 + (b) * 2 + (h)) * HTB)
#define PG8_STAGE(bufoff, gbase, voff) do { _Pragma("unroll") for (int _i = 0; _i < 2; ++_i) \
        __builtin_amdgcn_global_load_lds((const unsigned*)((const char*)(gbase) + (voff)[_i]), (PG8_LAS unsigned*)(lds + (bufoff) + ldsw + _i * 8192), 16, 0, 0); } while (0)
#define PG8_LDA(dst, b, h) do { _Pragma("unroll") for (int m = 0; m < 4; ++m) _Pragma("unroll") for (int k = 0; k < 2; ++k) dst[m][k] = *(const PG8_LAS bf16x8*)(lds + PG8_SA(b, h) + aoff + m * 2048 + k * 1024); } while (0)
#define PG8_LDB(dst, b, h) do { _Pragma("unroll") for (int n = 0; n < 2; ++n) _Pragma("unroll") for (int k = 0; k < 2; ++k) dst[n][k] = *(const PG8_LAS bf16x8*)(lds + PG8_SB(b, h) + boff + n * 2048 + k * 1024); } while (0)
#define PG8_MMA(ai, bj, At, Bt) do { __builtin_amdgcn_s_setprio(1); _Pragma("unroll") for (int m = 0; m < 4; ++m) _Pragma("unroll") for (int n = 0; n < 2; ++n) _Pragma("unroll") for (int k = 0; k < 2; ++k) \
        acc[ai][bj][m][n] = __builtin_amdgcn_mfma_f32_16x16x32_bf16(Bt[n][k], At[m][k], acc[ai][bj][m][n], 0, 0, 0); __builtin_amdgcn_s_setprio(0); } while (0)
#define PG8_WAIT_V(n) asm volatile("s_waitcnt vmcnt(" #n ")" ::: "memory")
#define PG8_WAIT_L(n) asm volatile("s_waitcnt lgkmcnt(" #n ")" ::: "memory")
#define PG8_BAR __builtin_amdgcn_s_barrier()
#define PG8_SCHED __builtin_amdgcn_sched_barrier(0)
    Unit cur, nxt; int ui = 0;
    if (!S.next(0, cur)) return;
    f32x4 acc[2][2][4][2];
#pragma unroll
    for (int a = 0; a < 2; ++a)
#pragma unroll
        for (int b = 0; b < 2; ++b)
#pragma unroll
            for (int m = 0; m < 4; ++m)
#pragma unroll
                for (int n = 0; n < 2; ++n) acc[a][b][m][n] = (f32x4){0.f, 0.f, 0.f, 0.f};
    bf16x8 At[4][2], B0[2][2], B1[2][2];
    const char* cA = (const char*)g.A + (size_t)cur.pm * tstep; const char* cB = (const char*)g.Bt + (size_t)cur.pn * tstep;
    S.a_ready(cur);
    if constexpr (SP2) {
        PG8_STAGE(PG8_SB(0, 0), cB, voffB); PG8_STAGE(PG8_SB(0, 1), cB + hstep, voffB); PG8_STAGE(PG8_SA(0, 0), cA, voffA); PG8_STAGE(PG8_SA(0, 1), cA + hstep, voffA);
        if (wr == 1) PG8_BAR;
        PG8_WAIT_V(2); PG8_BAR;
        PG8_STAGE(PG8_SB(1, 0), cB + kstep, voffB); PG8_STAGE(PG8_SA(1, 0), cA + kstep, voffA); PG8_STAGE(PG8_SB(1, 1), cB + hstep + kstep, voffB);
        PG8_WAIT_V(6); PG8_BAR;
    } else {
        PG8_STAGE(PG8_SB(0, 0), cB, voffB); PG8_STAGE(PG8_SA(0, 0), cA, voffA); PG8_STAGE(PG8_SB(0, 1), cB + hstep, voffB); PG8_STAGE(PG8_SA(0, 1), cA + hstep, voffA);
        if (wr == 1) PG8_BAR;
        PG8_WAIT_V(4); PG8_BAR;
        PG8_STAGE(PG8_SB(1, 0), cB + kstep, voffB); PG8_STAGE(PG8_SA(1, 0), cA + kstep, voffA); PG8_STAGE(PG8_SB(1, 1), cB + hstep + kstep, voffB);
        PG8_WAIT_V(6); PG8_BAR;
    }
    for (;;) {
        const bool has_next = S.next(ui + 1, nxt);
        const char* nA = has_next ? (const char*)g.A + (size_t)nxt.pm * tstep : cA; const char* nB = has_next ? (const char*)g.Bt + (size_t)nxt.pn * tstep : cB;
        for (int t = 0; t < nt; t += 2) {
            const bool last = (t == nt - 2);
            const char* a1 = cA + (size_t)(t + 1) * kstep;
            const char* a2 = last ? nA : cA + (size_t)(t + 2) * kstep; const char* b2 = last ? nB : cB + (size_t)(t + 2) * kstep;
            const char* a3 = a2 + kstep; const char* b3 = b2 + kstep;
            if (last && has_next) S.a_ready(nxt);
            if constexpr (SP2) {
            PG8_LDB(B0, 0, 0); PG8_LDB(B1, 0, 1); PG8_SCHED; PG8_LDA(At, 0, 0); PG8_STAGE(PG8_SA(1, 1), a1 + hstep, voffA);
            PG8_WAIT_V(8); PG8_WAIT_L(0); PG8_BAR; PG8_MMA(0, 0, At, B0); PG8_MMA(0, 1, At, B1); PG8_BAR; PG8_SCHED;
            PG8_LDA(At, 0, 1); PG8_STAGE(PG8_SB(0, 0), b2, voffB); PG8_STAGE(PG8_SB(0, 1), b2 + hstep, voffB); PG8_STAGE(PG8_SA(0, 0), a2, voffA);
            PG8_WAIT_V(8); PG8_WAIT_L(0); PG8_BAR; PG8_MMA(1, 0, At, B0); PG8_MMA(1, 1, At, B1); PG8_BAR; PG8_SCHED;
            PG8_LDB(B0, 1, 0); PG8_LDB(B1, 1, 1); PG8_SCHED; PG8_LDA(At, 1, 0); PG8_STAGE(PG8_SA(0, 1), a2 + hstep, voffA);
            PG8_WAIT_V(8); PG8_WAIT_L(0); PG8_BAR; PG8_MMA(0, 0, At, B0); PG8_MMA(0, 1, At, B1); PG8_BAR; PG8_SCHED;
            PG8_LDA(At, 1, 1); PG8_STAGE(PG8_SB(1, 0), b3, voffB); PG8_STAGE(PG8_SB(1, 1), b3 + hstep, voffB); PG8_STAGE(PG8_SA(1, 0), a3, voffA);
            PG8_WAIT_V(8); PG8_WAIT_L(0); PG8_BAR; PG8_MMA(1, 0, At, B0); PG8_MMA(1, 1, At, B1); PG8_BAR; PG8_SCHED;
            } else {
            PG8_LDB(B0, 0, 0); PG8_SCHED; PG8_LDA(At, 0, 0); PG8_STAGE(PG8_SA(1, 1), a1 + hstep, voffA);
            PG8_WAIT_L(8); PG8_BAR; PG8_WAIT_L(0); PG8_MMA(0, 0, At, B0); PG8_BAR; PG8_SCHED;
            PG8_LDB(B1, 0, 1); PG8_STAGE(PG8_SB(0, 0), b2, voffB);
            PG8_BAR; PG8_WAIT_L(0); PG8_MMA(0, 1, At, B1); PG8_BAR;
            PG8_LDA(At, 0, 1); PG8_STAGE(PG8_SA(0, 0), a2, voffA);
            PG8_BAR; PG8_WAIT_L(0); PG8_MMA(1, 0, At, B0); PG8_BAR; PG8_SCHED;
            PG8_STAGE(PG8_SB(0, 1), b2 + hstep, voffB);
            PG8_WAIT_V(6); PG8_BAR; PG8_MMA(1, 1, At, B1); PG8_BAR;
            PG8_LDB(B0, 1, 0); PG8_SCHED; PG8_LDA(At, 1, 0); PG8_STAGE(PG8_SA(0, 1), a2 + hstep, voffA);
            PG8_WAIT_L(8); PG8_BAR; PG8_WAIT_L(0); PG8_MMA(0, 0, At, B0); PG8_BAR; PG8_SCHED;
            PG8_LDB(B1, 1, 1); PG8_STAGE(PG8_SB(1, 0), b3, voffB);
            PG8_BAR; PG8_WAIT_L(0); PG8_MMA(0, 1, At, B1); PG8_BAR;
            PG8_LDA(At, 1, 1); PG8_STAGE(PG8_SA(1, 0), a3, voffA);
            PG8_BAR; PG8_WAIT_L(0); PG8_MMA(1, 0, At, B0); PG8_BAR; PG8_SCHED;
            PG8_STAGE(PG8_SB(1, 1), b3 + hstep, voffB);
            PG8_WAIT_V(6); PG8_BAR; PG8_MMA(1, 1, At, B1); PG8_BAR;
            }
        }
        if constexpr (ALIGN_EPI) { if (wr == 0) PG8_BAR; }
        if constexpr (!Epi::AFTER_DRAIN) { E(acc, cur, wr, wc, fr, fq); S.done(cur); }
        if (!has_next) break;
#pragma unroll
        for (int a = 0; a < 2; ++a)
#pragma unroll
            for (int b = 0; b < 2; ++b)
#pragma unroll
                for (int m = 0; m < 4; ++m)
#pragma unroll
                    for (int n = 0; n < 2; ++n) acc[a][b][m][n] = (f32x4){0.f, 0.f, 0.f, 0.f};
        cur = nxt; cA = nA; cB = nB; ++ui;
        if constexpr (ALIGN_EPI) { if (wr == 1) PG8_BAR; }
    }
    PG8_WAIT_V(0);
    if constexpr (!ALIGN_EPI) { if (wr == 0) PG8_BAR; }
    PG8_BAR;
    if constexpr (Epi::AFTER_DRAIN) { E.fused(acc, cur, wr, wc, fr, fq, lds, wid, lane); S.done(cur); }
#undef PG8_SA
#undef PG8_SB
#undef PG8_STAGE
#undef PG8_LDA
#undef PG8_LDB
#undef PG8_MMA
#undef PG8_WAIT_V
#undef PG8_WAIT_L
#undef PG8_BAR
#undef PG8_SCHED
}
}
#define XB_TMO      128
#define XB_XCNT(j)  (256  + 64 * (j))
#define XB_XSUB(j)  (1280 + 64 * (j))
#define XB_XGEN(j)  (2304 + 64 * (j))
#define XB_TOP      3328
#define XB_TOPGEN   3392
#define XCD_BAR_WORDS 3456
#define XB_SPIN_CAP (1u << 18)

__device__ __forceinline__ unsigned xb_ld(unsigned* p)              { return __hip_atomic_load(p, __ATOMIC_RELAXED, __HIP_MEMORY_SCOPE_AGENT); }
__device__ __forceinline__ unsigned xb_add(unsigned* p, unsigned v) { return __hip_atomic_fetch_add(p, v, __ATOMIC_RELAXED, __HIP_MEMORY_SCOPE_AGENT); }
__device__ __forceinline__ unsigned xb_xcc_id() { return (unsigned)__builtin_amdgcn_s_getreg((3 << 11) | 20) & 0xFu; }
#define XB_SPIN(cond, bar) do { unsigned _sp = 0; while (cond) { __builtin_amdgcn_s_sleep(1); \
    if ((++_sp & 255u) == 0u) { if (xb_ld(&(bar)[XB_TMO])) break; if (_sp > XB_SPIN_CAP) { atomicAdd(&(bar)[XB_TMO], 1u); break; } } } } while (0)

struct XcdBarrier {
    unsigned* bar; unsigned x;
    volatile LAS unsigned* st;
};

__device__ __forceinline__ XcdBarrier xcd_barrier_post(unsigned* bar, volatile LAS unsigned* st) {
    XcdBarrier b; b.bar = bar; b.x = xb_xcc_id(); b.st = st;
    if (threadIdx.x == 0) (void)xb_add(&bar[XB_XCNT(b.x)], 1u);
    return b;
}
__device__ __forceinline__ void xcd_barrier_complete(unsigned* bar, unsigned x, unsigned& nloc, unsigned& nx) {
    const unsigned G = gridDim.x * gridDim.y * gridDim.z;
    unsigned sum, cnt, mine, sp = 0u;
    for (;;) {
        sum = 0u; cnt = 0u; mine = 0u;
#pragma unroll
        for (unsigned j = 0; j < 16; ++j) { const unsigned c = xb_ld(&bar[XB_XCNT(j)]); sum += c; cnt += (c > 0u) ? 1u : 0u; mine = (j == x) ? c : mine; }
        if (sum == G) break;
        __builtin_amdgcn_s_sleep(1);
        if ((++sp & 255u) == 0u) { if (xb_ld(&bar[XB_TMO])) break; if (sp > XB_SPIN_CAP) { atomicAdd(&bar[XB_TMO], 1u); break; } }
    }
    nloc = mine > 0u ? mine : 1u; nx = cnt > 0u ? cnt : 1u;
}

__device__ __forceinline__ void xcd_barrier(const XcdBarrier& b) {
    asm volatile("s_waitcnt vmcnt(0)" ::: "memory");
    __syncthreads();
    if (threadIdx.x == 0) {
        unsigned* bar = b.bar;
        __builtin_amdgcn_s_waitcnt(0);
        unsigned nloc = b.st[0], nx = b.st[1];
        if (nloc == 0u) { xcd_barrier_complete(bar, b.x, nloc, nx); b.st[0] = nloc; b.st[1] = nx; }
        const unsigned old = xb_add(&bar[XB_XSUB(b.x)], 1u);
        const unsigned gen = old / nloc;
        if (old + 1u == (gen + 1u) * nloc) {
            __builtin_amdgcn_fence(__ATOMIC_RELEASE, "agent");
            asm volatile("s_waitcnt vmcnt(0)" ::: "memory");
            const unsigned og = xb_add(&bar[XB_TOP], 1u);
            const unsigned tg = og / nx;
            if (og + 1u == (tg + 1u) * nx) xb_add(&bar[XB_TOPGEN], 1u);
            else XB_SPIN(xb_ld(&bar[XB_TOPGEN]) == tg, bar);
            __builtin_amdgcn_fence(__ATOMIC_ACQUIRE, "agent");
            xb_add(&bar[XB_XGEN(b.x)], 1u);
            asm volatile("s_waitcnt vmcnt(0)" ::: "memory");
        } else {
            XB_SPIN(xb_ld(&bar[XB_XGEN(b.x)]) == gen, bar);
            __builtin_amdgcn_fence(__ATOMIC_ACQUIRE, "agent");
            asm volatile("s_waitcnt vmcnt(0)" ::: "memory");
        }
    }
    __syncthreads();
}

__device__ __forceinline__ void tr_item(const float* W, int K, int N, bf16_t* WT, LAS float* scr, int item, int nblk, int lane, const float* gk, int headcols = 0) {
    const int kb = item / nblk, nb = item % nblk, k0 = 64 * kb, n0 = 32 * nb;
    const int n_in = n0 + (lane & 31);
    int r0 = n0; if (n0 < headcols) r0 = (n0 & ~255) + 128 * ((n0 & 63) >> 5) + 32 * ((n0 & 255) >> 6);
    if (headcols < 0) { const int isv = n0 >= D_FF ? 1 : 0, ch0 = n0 - isv * D_FF; r0 = 256 * (ch0 >> 7) + 128 * isv + (ch0 & 127); }
#pragma unroll
    for (int i = 0; i < 32; ++i) { const int kk = 2 * i + (lane >> 5); scr[kk * 33 + (lane & 31)] = (n_in < N) ? W[(size_t)(k0 + kk) * N + n_in] : 0.f; }
    LDS_WAIT(); asm volatile("" ::: "memory");
    const int c = lane & 7;
    v4f ga = {1.f, 1.f, 1.f, 1.f}, gb = ga;
    if (gk) { ga = *(const v4f*)(gk + k0 + 8 * c); gb = *(const v4f*)(gk + k0 + 8 * c + 4); }
#pragma unroll
    for (int j = 0; j < 4; ++j) { const int n = (lane >> 3) + 8 * j; const LAS float* s = scr + (8 * c) * 33 + n;
        v4u o; o.x = pk2(s[0 * 33] * ga.x, s[1 * 33] * ga.y); o.y = pk2(s[2 * 33] * ga.z, s[3 * 33] * ga.w); o.z = pk2(s[4 * 33] * gb.x, s[5 * 33] * gb.y); o.w = pk2(s[6 * 33] * gb.z, s[7 * 33] * gb.w);
        *(v4u*)(WT + (size_t)(r0 + n) * K + k0 + 8 * c) = o; }
    LDS_WAIT(); asm volatile("" ::: "memory");
}
__device__ __forceinline__ void xb_row(const float* xrow, bf16_t* orow, float* ssq, int lane) {
    const v4f* xr = (const v4f*)xrow + lane;
    v4f v[4]; float s = 0.f;
#pragma unroll
    for (int j = 0; j < 4; ++j) { v[j] = xr[64 * j]; s += (v[j].x * v[j].x + v[j].y * v[j].y) + (v[j].z * v[j].z + v[j].w * v[j].w); }
    s = wave_sum(s);
    v2u* o8 = (v2u*)orow + lane;
#pragma unroll
    for (int j = 0; j < 4; ++j) { v2u o; o.x = pk2(v[j].x, v[j].y); o.y = pk2(v[j].z, v[j].w); o8[64 * j] = o; }
    if (lane < 16) ssq[lane] = lane == 0 ? s : 0.f;
}
__device__ __forceinline__ void xb_rows4(const float* __restrict__ x, bf16_t* __restrict__ xb, float* __restrict__ ssq, int m0, int mstride, int lane) {
    v4f v[4][4];
#pragma unroll
    for (int r = 0; r < 4; ++r) { int row = m0 + r * mstride; row = row < M_TOK ? row : M_TOK - 1; const v4f* xr = (const v4f*)(x + (size_t)row * D_MODEL) + lane;
#pragma unroll
        for (int j = 0; j < 4; ++j) v[r][j] = xr[64 * j]; }
#pragma unroll
    for (int r = 0; r < 4; ++r) { const int row = m0 + r * mstride;
        if (row < M_TOK) { float s = 0.f;
#pragma unroll
            for (int j = 0; j < 4; ++j) s += (v[r][j].x * v[r][j].x + v[r][j].y * v[r][j].y) + (v[r][j].z * v[r][j].z + v[r][j].w * v[r][j].w);
            s = wave_sum(s);
            v2u* o8 = (v2u*)(xb + (size_t)row * D_MODEL) + lane;
#pragma unroll
            for (int j = 0; j < 4; ++j) { v2u o; o.x = pk2(v[r][j].x, v[r][j].y); o.y = pk2(v[r][j].z, v[r][j].w); o8[64 * j] = o; }
            if (lane < 16) ssq[(size_t)row * 16 + lane] = lane == 0 ? s : 0.f; } }
}
__device__ __forceinline__ void rope_fill(float* ROPE, int gw, int NGW, int lane) {
    for (int it = gw * 64 + lane; it < SEQ * 16; it += NGW * 64) { const int pos = it >> 4, i = it & 15; float sn, cs; sincosf((float)pos * c_inv[i], &sn, &cs);
        ROPE[pos * 32 + i] = cs; ROPE[pos * 32 + 16 + i] = sn; }
}
__device__ __forceinline__ void unpack8(const v4u w, float (&x)[8]) { x[0] = bflo(w.x); x[1] = bfhi(w.x); x[2] = bflo(w.y); x[3] = bfhi(w.y); x[4] = bflo(w.z); x[5] = bfhi(w.z); x[6] = bflo(w.w); x[7] = bfhi(w.w); }
__device__ __forceinline__ v4u pack8(const float (&x)[8]) { v4u w; w.x = pk2(x[0], x[1]); w.y = pk2(x[2], x[3]); w.z = pk2(x[4], x[5]); w.w = pk2(x[6], x[7]); return w; }

struct AcIn { v4u q0, q1, k0, k1, v0, v1, qi, ki; float cs[8], sn[8]; float wi; };
template <bool IDX>
__device__ __forceinline__ void ac_load(AcIn& in, const bf16_t* S, int row, const float* ROPE, int lane) {
    const v4u* sq = (const v4u*)(S + 16 * lane); const v4u* sk = (const v4u*)(S + 1024 + 16 * lane); const v4u* sv = (const v4u*)(S + 2048 + 16 * lane);
    in.q0 = sq[0]; in.q1 = sq[1]; in.k0 = sk[0]; in.k1 = sk[1]; in.v0 = sv[0]; in.v1 = sv[1];
    if (IDX) {
        const int pos = row % SEQ; const float* rp = ROPE + pos * 32; const int l8 = lane & 7, ib = (l8 & 1) * 8;
        in.qi = *(const v4u*)(S + 3072 + 8 * lane); in.ki = *(const v4u*)(S + 3584 + 8 * l8); in.wi = bf2f(S[3648 + l8]);
#pragma unroll
        for (int e = 0; e < 8; ++e) { in.cs[e] = rp[ib + e]; in.sn[e] = rp[16 + ib + e]; }
    }
}
template <bool IDX>
__device__ __forceinline__ void ac_compute(const AcIn& in, int row, const float* qg, const float* kg, const float* kig,
                                           bf16_t* Q, bf16_t* K, bf16_t* V, bf16_t* QI, bf16_t* KI, float* WI, int lane) {
#pragma unroll
    for (int t = 0; t < 2; ++t) {
        float x[16]; { float a[8], b[8]; unpack8(t ? in.k0 : in.q0, a); unpack8(t ? in.k1 : in.q1, b);
#pragma unroll
            for (int e = 0; e < 8; ++e) { x[e] = a[e]; x[8 + e] = b[e]; } }
        float ss = 0.f;
#pragma unroll
        for (int e = 0; e < 16; ++e) ss += x[e] * x[e];
        ss += __shfl_xor(ss, 1); ss += __shfl_xor(ss, 2);
        const float r = (1.0f / sqrtf(ss * (1.0f / 64.0f) + EPS)) * (t ? 1.0f : 0.125f * 1.4426950408889634f);
        const float* g = (t ? kg : qg) + (lane & 3) * 16;
        float a[8], b[8];
#pragma unroll
        for (int e = 0; e < 8; ++e) { a[e] = x[e] * r * g[e]; b[e] = x[8 + e] * r * g[8 + e]; }
        v4u* op = (v4u*)((t ? K : Q) + (size_t)row * 1024 + 16 * lane);
        op[0] = pack8(a); op[1] = pack8(b);
    }
    { v4u* op = (v4u*)(V + (size_t)row * 1024 + 16 * lane); op[0] = in.v0; op[1] = in.v1; }
    if (IDX) {
        const int pos = row % SEQ; const int l8 = lane & 7;
        { float x[8], xp[8], o[8]; unpack8(in.qi, x);
#pragma unroll
            for (int e = 0; e < 8; ++e) xp[e] = __shfl_xor(x[e], 2);
#pragma unroll
            for (int e = 0; e < 8; ++e) o[e] = (l8 < 4) ? x[e] : ((l8 < 6) ? (x[e] * in.cs[e] - xp[e] * in.sn[e]) : (xp[e] * in.sn[e] + x[e] * in.cs[e]));
            *(v4u*)(QI + (size_t)row * 512 + 8 * lane) = pack8(o); }
        { float x[8], y[8], yp[8], o[8]; unpack8(in.ki, x);
            float ss = 0.f;
#pragma unroll
            for (int e = 0; e < 8; ++e) ss += x[e] * x[e];
            ss += __shfl_xor(ss, 1); ss += __shfl_xor(ss, 2); ss += __shfl_xor(ss, 4);
            const float r = 1.0f / sqrtf(ss * (1.0f / 64.0f) + EPS);
#pragma unroll
            for (int e = 0; e < 8; ++e) y[e] = x[e] * r * kig[l8 * 8 + e];
#pragma unroll
            for (int e = 0; e < 8; ++e) yp[e] = __shfl_xor(y[e], 2);
#pragma unroll
            for (int e = 0; e < 8; ++e) o[e] = (l8 < 4) ? y[e] : ((l8 < 6) ? (y[e] * in.cs[e] - yp[e] * in.sn[e]) : (yp[e] * in.sn[e] + y[e] * in.cs[e]));
            if (lane < 8) *(v4u*)(KI + (size_t)(row - pos) * 64 + (size_t)(((pos >> 5) * 4 + (lane >> 1)) * 64 + (lane & 1) * 32 + (pos & 31)) * 8) = pack8(o); }
        if (lane < 8) WI[(size_t)row * 8 + lane] = in.wi;
    }
}
template <bool IDX>
__device__ __forceinline__ void post_ac_rows(const bf16_t* SB, int ld, int gw, int NGW, const float* qg, const float* kg, const float* kig, const float* ROPE,
                                             bf16_t* Q, bf16_t* K, bf16_t* V, bf16_t* QI, bf16_t* KI, float* WI, int lane) {
    AcIn cur = AcIn{}, nxt = AcIn{};
    if (gw < M_TOK) ac_load<IDX>(cur, SB + (size_t)gw * ld, gw, ROPE, lane);
    for (int m = gw; m < M_TOK; m += NGW) {
        const int mn = m + NGW;
        if (mn < M_TOK) ac_load<IDX>(nxt, SB + (size_t)mn * ld, mn, ROPE, lane);
        ac_compute<IDX>(cur, m, qg, kg, kig, Q, K, V, QI, KI, WI, lane);
        cur = nxt;
    }
}
struct IdxIn { v4u qi, ki; float cs[8], sn[8]; float wi; };
__device__ __forceinline__ void idx_load(IdxIn& in, const bf16_t* S, int row, const float* ROPE, int lane) {
    const int pos = row % SEQ; const float* rp = ROPE + pos * 32; const int l8 = lane & 7, ib = (l8 & 1) * 8;
    in.qi = *(const v4u*)(S + 8 * lane); in.ki = *(const v4u*)(S + 512 + 8 * l8); in.wi = bf2f(S[576 + l8]);
#pragma unroll
    for (int e = 0; e < 8; ++e) { in.cs[e] = rp[ib + e]; in.sn[e] = rp[16 + ib + e]; }
}
__device__ __forceinline__ void idx_compute(const IdxIn& in, int row, const float* kig, bf16_t* QI, bf16_t* KI, float* WI, int lane) {
    const int pos = row % SEQ; const int l8 = lane & 7;
    { float x[8], xp[8], o[8]; unpack8(in.qi, x);
#pragma unroll
        for (int e = 0; e < 8; ++e) xp[e] = __shfl_xor(x[e], 2);
#pragma unroll
        for (int e = 0; e < 8; ++e) o[e] = (l8 < 4) ? x[e] : ((l8 < 6) ? (x[e] * in.cs[e] - xp[e] * in.sn[e]) : (xp[e] * in.sn[e] + x[e] * in.cs[e]));
        *(v4u*)(QI + (size_t)row * 512 + 8 * lane) = pack8(o); }
    { float x[8], y[8], yp[8], o[8]; unpack8(in.ki, x);
        float ss = 0.f;
#pragma unroll
        for (int e = 0; e < 8; ++e) ss += x[e] * x[e];
        ss += __shfl_xor(ss, 1); ss += __shfl_xor(ss, 2); ss += __shfl_xor(ss, 4);
        const float r = 1.0f / sqrtf(ss * (1.0f / 64.0f) + EPS);
#pragma unroll
        for (int e = 0; e < 8; ++e) y[e] = x[e] * r * kig[l8 * 8 + e];
#pragma unroll
        for (int e = 0; e < 8; ++e) yp[e] = __shfl_xor(y[e], 2);
#pragma unroll
        for (int e = 0; e < 8; ++e) o[e] = (l8 < 4) ? y[e] : ((l8 < 6) ? (y[e] * in.cs[e] - yp[e] * in.sn[e]) : (yp[e] * in.sn[e] + y[e] * in.cs[e]));
        if (lane < 8) *(v4u*)(KI + (size_t)(row - pos) * 64 + (size_t)(((pos >> 5) * 4 + (lane >> 1)) * 64 + (lane & 1) * 32 + (pos & 31)) * 8) = pack8(o); }
    if (lane < 8) WI[(size_t)row * 8 + lane] = in.wi;
}
__device__ __forceinline__ void post_idx_rows(const bf16_t* SB, int ld, int gw, int NGW, const float* kig, const float* ROPE, bf16_t* QI, bf16_t* KI, float* WI, int lane) {
    for (int m = gw; m < M_TOK; m += 4 * NGW) {
        IdxIn in[4];
#pragma unroll
        for (int r = 0; r < 4; ++r) { int row = m + r * NGW; row = row < M_TOK ? row : M_TOK - 1; idx_load(in[r], SB + (size_t)row * ld, row, ROPE, lane); }
#pragma unroll
        for (int r = 0; r < 4; ++r) { const int row = m + r * NGW; if (row < M_TOK) idx_compute(in[r], row, kig, QI, KI, WI, lane); }
    }
}
__device__ __forceinline__ void post_b1_row(const bf16_t* __restrict__ S, int row, const float* __restrict__ qag, const float* __restrict__ kvag, bf16_t* __restrict__ CQN, bf16_t* __restrict__ CKVN, float* __restrict__ KR, int lane) {
    { const v2u w = *(const v2u*)(S + 4 * lane); const float x0 = bflo(w.x), x1 = bfhi(w.x), x2 = bflo(w.y), x3 = bfhi(w.y);
        const float r = 1.0f / sqrtf(wave_sum((x0 * x0 + x1 * x1) + (x2 * x2 + x3 * x3)) * (1.0f / 256.0f) + EPS);
        const v4f g = *(const v4f*)(qag + 4 * lane); v2u o; o.x = pk2(x0 * r * g.x, x1 * r * g.y); o.y = pk2(x2 * r * g.z, x3 * r * g.w);
        *(v2u*)(CQN + (size_t)row * 256 + 4 * lane) = o; }
    { const unsigned w = *(const unsigned*)(S + 256 + 2 * lane); const float x0 = bflo(w), x1 = bfhi(w);
        const float r = 1.0f / sqrtf(wave_sum(x0 * x0 + x1 * x1) * (1.0f / 128.0f) + EPS);
        *(unsigned*)(CKVN + (size_t)row * 128 + 2 * lane) = pk2(x0 * r * kvag[2 * lane], x1 * r * kvag[2 * lane + 1]); }
    if (lane < 32) KR[(size_t)row * 32 + lane] = bf2f(S[384 + lane]);
}
template <int R>
__device__ __forceinline__ void post_b1_rows(const bf16_t* __restrict__ SB, int m0, int mstride, const float* __restrict__ qag, const float* __restrict__ kvag, bf16_t* __restrict__ CQN, bf16_t* __restrict__ CKVN, float* __restrict__ KR, int lane) {
    v2u w[R]; unsigned w2[R]; bf16_t kr[R];
#pragma unroll
    for (int r = 0; r < R; ++r) { const int row = m0 + r * mstride; w[r] = (v2u){0u, 0u}; w2[r] = 0u; kr[r] = 0;
        if (row < M_TOK) { const bf16_t* S = SB + (size_t)row * B_DOWNP; w[r] = *(const v2u*)(S + 4 * lane); w2[r] = *(const unsigned*)(S + 256 + 2 * lane); kr[r] = S[384 + (lane & 31)]; } }
    const v4f g = *(const v4f*)(qag + 4 * lane); const float kg0 = kvag[2 * lane], kg1 = kvag[2 * lane + 1];
#pragma unroll
    for (int r = 0; r < R; ++r) { const int row = m0 + r * mstride;
        if (row < M_TOK) {
            { const float x0 = bflo(w[r].x), x1 = bfhi(w[r].x), x2 = bflo(w[r].y), x3 = bfhi(w[r].y);
              const float rs = 1.0f / sqrtf(wave_sum((x0 * x0 + x1 * x1) + (x2 * x2 + x3 * x3)) * (1.0f / 256.0f) + EPS);
              v2u o; o.x = pk2(x0 * rs * g.x, x1 * rs * g.y); o.y = pk2(x2 * rs * g.z, x3 * rs * g.w);
              *(v2u*)(CQN + (size_t)row * 256 + 4 * lane) = o; }
            { const float x0 = bflo(w2[r]), x1 = bfhi(w2[r]);
              const float rs = 1.0f / sqrtf(wave_sum(x0 * x0 + x1 * x1) * (1.0f / 128.0f) + EPS);
              *(unsigned*)(CKVN + (size_t)row * 128 + 2 * lane) = pk2(x0 * rs * kg0, x1 * rs * kg1); }
            if (lane < 32) KR[(size_t)row * 32 + lane] = bf2f(kr[r]);
        } }
}
__device__ __forceinline__ void post_b2_row(const bf16_t* __restrict__ SQ, const bf16_t* __restrict__ SKV, const float* __restrict__ kr, int row, const float* __restrict__ qg, const float* __restrict__ kg, const float* __restrict__ ROPE,
                                            bf16_t* __restrict__ QB, bf16_t* __restrict__ KB, bf16_t* __restrict__ VB, int lane) {
    const int pos = row % SEQ; const float* rp = ROPE + pos * 32;
    const int hn = lane >> 2, part = lane & 3;
    const int l5 = lane & 31, hr = l5 >> 1, half = l5 & 1;
    float cs[8], sn[8];
#pragma unroll
    for (int e = 0; e < 8; ++e) { cs[e] = rp[8 * half + e]; sn[e] = rp[16 + 8 * half + e]; }
    for (int t = 1; t < 2; ++t) {
        float x[16], x1[8], x2[8];
        { const bf16_t* np = t ? (SKV + hn * 128 + part * 16) : (SQ + hn * 96 + part * 16); float a[8], b[8]; unpack8(((const v4u*)np)[0], a); unpack8(((const v4u*)np)[1], b);
#pragma unroll
            for (int e = 0; e < 8; ++e) { x[e] = a[e]; x[8 + e] = b[e]; } }
        if (t) {
#pragma unroll
            for (int e = 0; e < 8; ++e) { x1[e] = kr[8 * half + e]; x2[e] = kr[16 + 8 * half + e]; }
        } else { unpack8(*(const v4u*)(SQ + hr * 96 + 64 + 8 * half), x1); unpack8(*(const v4u*)(SQ + hr * 96 + 80 + 8 * half), x2); }
        float sn_ = 0.f, sr_ = 0.f;
#pragma unroll
        for (int e = 0; e < 16; ++e) sn_ += x[e] * x[e];
#pragma unroll
        for (int e = 0; e < 8; ++e) sr_ += x1[e] * x1[e] + x2[e] * x2[e];
        sn_ += __shfl_xor(sn_, 1); sn_ += __shfl_xor(sn_, 2);
        sr_ += __shfl_xor(sr_, 1);
        const float tot_n = sn_ + __shfl(sr_, 2 * hn);
        const float tot_r = sr_ + __shfl(sn_, 4 * hr);
        const float qs = t ? 1.0f : 0.10206207261596577f * 1.4426950408889634f;
        const float rn = qs / sqrtf(tot_n * (1.0f / 96.0f) + EPS), rr = qs / sqrtf(tot_r * (1.0f / 96.0f) + EPS);
        const float* g = t ? kg : qg;
        bf16_t* out = (t ? KB : QB) + (size_t)row * 1536;
        { float a[8], b[8];
#pragma unroll
            for (int e = 0; e < 8; ++e) { a[e] = x[e] * rn * g[part * 16 + e]; b[e] = x[8 + e] * rn * g[part * 16 + 8 + e]; }
            v4u* op = (v4u*)(out + hn * 96 + part * 16); op[0] = pack8(a); op[1] = pack8(b); }
        { float o1[8], o2[8];
#pragma unroll
            for (int e = 0; e < 8; ++e) { const float y1 = x1[e] * rr * g[64 + 8 * half + e], y2 = x2[e] * rr * g[80 + 8 * half + e]; o1[e] = y1 * cs[e] - y2 * sn[e]; o2[e] = y1 * sn[e] + y2 * cs[e]; }
            if (lane < 32) { *(v4u*)(out + hr * 96 + 64 + 8 * half) = pack8(o1); *(v4u*)(out + hr * 96 + 80 + 8 * half) = pack8(o2); } }
    }
}
template <int R>
__device__ __forceinline__ void post_b2k_rows(const bf16_t* __restrict__ SKVB, const float* __restrict__ KRB, int m0, int mstride, const float* __restrict__ kg, const float* __restrict__ ROPE, bf16_t* __restrict__ KB, int lane) {
    const int hn = lane >> 2, part = lane & 3;
    const int l5 = lane & 31, hr = l5 >> 1, half = l5 & 1;
    v4u n0[R], n1[R]; v4f ka[R], kb[R], kc[R], kd[R], ca[R], cb2[R], sa[R], sb[R];
#pragma unroll
    for (int r = 0; r < R; ++r) { int row = m0 + r * mstride; row = row < M_TOK ? row : M_TOK - 1;
        const bf16_t* np = SKVB + (size_t)row * 2048 + hn * 128 + part * 16; n0[r] = ((const v4u*)np)[0]; n1[r] = ((const v4u*)np)[1];
        const float* kr = KRB + (size_t)row * 32; ka[r] = *(const v4f*)(kr + 8 * half); kb[r] = *(const v4f*)(kr + 8 * half + 4); kc[r] = *(const v4f*)(kr + 16 + 8 * half); kd[r] = *(const v4f*)(kr + 16 + 8 * half + 4);
        const float* rp = ROPE + (row % SEQ) * 32; ca[r] = *(const v4f*)(rp + 8 * half); cb2[r] = *(const v4f*)(rp + 8 * half + 4); sa[r] = *(const v4f*)(rp + 16 + 8 * half); sb[r] = *(const v4f*)(rp + 16 + 8 * half + 4); }
    float gn[16], g1[8], g2[8];
#pragma unroll
    for (int e = 0; e < 16; ++e) gn[e] = kg[part * 16 + e];
#pragma unroll
    for (int e = 0; e < 8; ++e) { g1[e] = kg[64 + 8 * half + e]; g2[e] = kg[80 + 8 * half + e]; }
#pragma unroll
    for (int r = 0; r < R; ++r) { const int row = m0 + r * mstride;
        float x[16], x1[8], x2[8], cs[8], sn[8];
        { float a[8], b[8]; unpack8(n0[r], a); unpack8(n1[r], b);
#pragma unroll
          for (int e = 0; e < 8; ++e) { x[e] = a[e]; x[8 + e] = b[e]; } }
#pragma unroll
        for (int e = 0; e < 4; ++e) { x1[e] = ka[r][e]; x1[4 + e] = kb[r][e]; x2[e] = kc[r][e]; x2[4 + e] = kd[r][e]; cs[e] = ca[r][e]; cs[4 + e] = cb2[r][e]; sn[e] = sa[r][e]; sn[4 + e] = sb[r][e]; }
        float sn_ = 0.f, sr_ = 0.f;
#pragma unroll
        for (int e = 0; e < 16; ++e) sn_ += x[e] * x[e];
#pragma unroll
        for (int e = 0; e < 8; ++e) sr_ += x1[e] * x1[e] + x2[e] * x2[e];
        sn_ += __shfl_xor(sn_, 1); sn_ += __shfl_xor(sn_, 2);
        sr_ += __shfl_xor(sr_, 1);
        const float tot_n = sn_ + __shfl(sr_, 2 * hn);
        const float tot_r = sr_ + __shfl(sn_, 4 * hr);
        const float rn = 1.0f / sqrtf(tot_n * (1.0f / 96.0f) + EPS), rr = 1.0f / sqrtf(tot_r * (1.0f / 96.0f) + EPS);
        if (row < M_TOK) {
            bf16_t* out = KB + (size_t)row * 1536;
            { float a[8], b[8];
#pragma unroll
              for (int e = 0; e < 8; ++e) { a[e] = x[e] * rn * gn[e]; b[e] = x[8 + e] * rn * gn[8 + e]; }
              v4u* op = (v4u*)(out + hn * 96 + part * 16); op[0] = pack8(a); op[1] = pack8(b); }
            { float o1[8], o2[8];
#pragma unroll
              for (int e = 0; e < 8; ++e) { const float y1 = x1[e] * rr * g1[e], y2 = x2[e] * rr * g2[e]; o1[e] = y1 * cs[e] - y2 * sn[e]; o2[e] = y1 * sn[e] + y2 * cs[e]; }
              if (lane < 32) { *(v4u*)(out + hr * 96 + 64 + 8 * half) = pack8(o1); *(v4u*)(out + hr * 96 + 80 + 8 * half) = pack8(o2); } }
        } }
}
__device__ __forceinline__ void kbuild_tile(const bf16_t* SKV, const float* KRB, const float* kg, const float* ROPE, bf16_t* KB, int pm, int pn) {
    const int lane = threadIdx.x & 63, w = threadIdx.x >> 6;
    const int row = 256 * pm + 32 * w + (lane & 31), h = 2 * pn + (lane >> 5);
    const v4u* np = (const v4u*)(SKV + (size_t)row * 2048 + h * 128);
    const v4f* kr4 = (const v4f*)(KRB + (size_t)row * 32); const v4f* rp4 = (const v4f*)(ROPE + (size_t)(row % SEQ) * 32);
    v4u nv[8]; v4f kr[8], rp[8];
#pragma unroll
    for (int i = 0; i < 8; ++i) { nv[i] = np[i]; kr[i] = kr4[i]; rp[i] = rp4[i]; }
    float ss = 0.f;
#pragma unroll
    for (int i = 0; i < 8; ++i) { float x[8]; unpack8(nv[i], x);
#pragma unroll
        for (int e = 0; e < 8; ++e) ss += x[e] * x[e];
        ss += (kr[i][0] * kr[i][0] + kr[i][1] * kr[i][1]) + (kr[i][2] * kr[i][2] + kr[i][3] * kr[i][3]); }
    const float rn = 1.0f / sqrtf(ss * (1.0f / 96.0f) + EPS);
    v4u* out = (v4u*)(KB + (size_t)row * 1536 + h * 96);
#pragma unroll
    for (int i = 0; i < 8; ++i) { float x[8]; unpack8(nv[i], x);
#pragma unroll
        for (int e = 0; e < 8; ++e) x[e] = x[e] * rn * kg[8 * i + e];
        out[i] = pack8(x); }
    float o1[16], o2[16];
#pragma unroll
    for (int i = 0; i < 16; ++i) { const float y1 = kr[i >> 2][i & 3] * rn * kg[64 + i], y2 = kr[4 + (i >> 2)][i & 3] * rn * kg[80 + i], cs = rp[i >> 2][i & 3], sn = rp[4 + (i >> 2)][i & 3];
        o1[i] = y1 * cs - y2 * sn; o2[i] = y1 * sn + y2 * cs; }
    { float a[8];
#pragma unroll
      for (int e = 0; e < 8; ++e) a[e] = o1[e];
      out[8] = pack8(a);
#pragma unroll
      for (int e = 0; e < 8; ++e) a[e] = o1[8 + e];
      out[9] = pack8(a);
#pragma unroll
      for (int e = 0; e < 8; ++e) a[e] = o2[e];
      out[10] = pack8(a);
#pragma unroll
      for (int e = 0; e < 8; ++e) a[e] = o2[8 + e];
      out[11] = pack8(a); }
}
struct KOrder { pg8::StaticOrder so; const bf16_t* SKV; const float* KRB; const float* kg; const float* ROPE; bf16_t* KB;
    __device__ __forceinline__ bool next(int i, pg8::Unit& u) const { return so.next(i, u); }
    __device__ __forceinline__ void a_ready(const pg8::Unit&) const {}
    __device__ __forceinline__ void done(const pg8::Unit& u) const {
        asm volatile("s_waitcnt vmcnt(0)" ::: "memory");
        __builtin_amdgcn_s_barrier();
        asm volatile("" ::: "memory");
        kbuild_tile(SKV, KRB, kg, ROPE, KB, u.pm, u.pn);
    }
};
__device__ __forceinline__ void idx_rope64(v4u (&v)[8], const v4f (&rp)[8]) {
    float a[16], b[16];
    { float x[8]; unpack8(v[4], x);
#pragma unroll
      for (int e = 0; e < 8; ++e) a[e] = x[e];
      unpack8(v[5], x);
#pragma unroll
      for (int e = 0; e < 8; ++e) a[8 + e] = x[e];
      unpack8(v[6], x);
#pragma unroll
      for (int e = 0; e < 8; ++e) b[e] = x[e];
      unpack8(v[7], x);
#pragma unroll
      for (int e = 0; e < 8; ++e) b[8 + e] = x[e]; }
    float o1[16], o2[16];
#pragma unroll
    for (int i = 0; i < 16; ++i) { const float cs = rp[i >> 2][i & 3], sn = rp[4 + (i >> 2)][i & 3]; o1[i] = a[i] * cs - b[i] * sn; o2[i] = a[i] * sn + b[i] * cs; }
    { float x[8];
#pragma unroll
      for (int e = 0; e < 8; ++e) x[e] = o1[e];
      v[4] = pack8(x);
#pragma unroll
      for (int e = 0; e < 8; ++e) x[e] = o1[8 + e];
      v[5] = pack8(x);
#pragma unroll
      for (int e = 0; e < 8; ++e) x[e] = o2[e];
      v[6] = pack8(x);
#pragma unroll
      for (int e = 0; e < 8; ++e) x[e] = o2[8 + e];
      v[7] = pack8(x); }
}
__device__ __forceinline__ void idxpost_tile(const bf16_t* SI, const float* kig, const float* ROPE, bf16_t* QI, bf16_t* KI, float* WI, int pm, int t) {
    int tid = threadIdx.x; asm volatile("" : "+v"(tid));
    if (t < 2) {
        for (int k = 0; k < 2; ++k) { const int i = tid + 512 * k, row = 256 * pm + (i & 255), hl = i >> 8;
            const v4u* sp = (const v4u*)(SI + (size_t)row * 768 + 256 * t + 64 * hl); const v4f* r4 = (const v4f*)(ROPE + (size_t)(row % SEQ) * 32);
            v4u v[8]; v4f rp[8];
#pragma unroll
            for (int j = 0; j < 8; ++j) { v[j] = sp[j]; rp[j] = r4[j]; }
            idx_rope64(v, rp);
            v4u* op = (v4u*)(QI + (size_t)row * 512 + (4 * t + hl) * 64);
#pragma unroll
            for (int j = 0; j < 8; ++j) op[j] = v[j]; }
    } else if (tid < 256) {
        const int row = 256 * pm + tid, pos = row % SEQ;
        const v4u* sp = (const v4u*)(SI + (size_t)row * 768 + 512); const v4f* r4 = (const v4f*)(ROPE + (size_t)pos * 32);
        v4u v[8]; v4f rp[8];
#pragma unroll
        for (int j = 0; j < 8; ++j) { v[j] = sp[j]; rp[j] = r4[j]; }
        const v4u wv = sp[8];
        float ss = 0.f;
#pragma unroll
        for (int j = 0; j < 8; ++j) { float x[8]; unpack8(v[j], x);
#pragma unroll
            for (int e = 0; e < 8; ++e) ss += x[e] * x[e]; }
        const float r = 1.0f / sqrtf(ss * (1.0f / 64.0f) + EPS);
#pragma unroll
        for (int j = 0; j < 8; ++j) { float x[8]; unpack8(v[j], x);
#pragma unroll
            for (int e = 0; e < 8; ++e) x[e] = x[e] * r * kig[8 * j + e];
            v[j] = pack8(x); }
        idx_rope64(v, rp);
#pragma unroll
        for (int j = 0; j < 8; ++j) *(v4u*)(KI + (size_t)(row - pos) * 64 + (size_t)(((pos >> 5) * 4 + (j >> 1)) * 64 + (j & 1) * 32 + (pos & 31)) * 8) = v[j];
        { float x[8]; unpack8(wv, x); v4f* wp = (v4f*)(WI + (size_t)row * 8); wp[0] = (v4f){x[0], x[1], x[2], x[3]}; wp[1] = (v4f){x[4], x[5], x[6], x[7]}; }
    }
}
constexpr size_t IDX_OFF_SI = 0, IDX_OFF_QI = (size_t)216 << 20, IDX_OFF_KI = (size_t)232 << 20, IDX_OFF_WI = (size_t)234 << 20;
struct IdxOrder { pg8::StaticOrder so; unsigned char* big; const float* kig; const float* ROPE; int first;
    __device__ __forceinline__ bool next(int i, pg8::Unit& u) const { return so.next(i, u); }
    __device__ __forceinline__ void a_ready(const pg8::Unit&) const {}
    __device__ __forceinline__ void done(const pg8::Unit& u) const {
        if (u.pn < first) return;
        asm volatile("s_waitcnt vmcnt(0)" ::: "memory");
        __builtin_amdgcn_s_barrier();
        asm volatile("" ::: "memory");
        unsigned char* b = big; asm volatile("" : "+s"(b));
        idxpost_tile((const bf16_t*)(b + IDX_OFF_SI), kig, ROPE, (bf16_t*)(b + IDX_OFF_QI), (bf16_t*)(b + IDX_OFF_KI), (float*)(b + IDX_OFF_WI), u.pm, u.pn - first);
    }
};
struct FfnConv { const float* wup; const float* wdn; const float* gffn; unsigned char* wup_dst; unsigned char* wdn_dst; LAS unsigned char* lds; int gw, NGW, lane, wave, sel;
    __device__ __forceinline__ void operator()(int k) const {
        if (k != sel) return;
        __syncthreads();
        int gw_ = gw, lane_ = lane; asm volatile("" : "+v"(lane_)); asm volatile("" : "+s"(gw_));
        LAS float* scr = (LAS float*)(lds + wave * 16384);
        for (int it = gw_; it < 16 * (UPW / 32); it += NGW) tr_item(wup, 1024, UPW, (bf16_t*)wup_dst, scr, it, UPW / 32, lane_, gffn, -1);
        for (int it = gw_; it < (D_FF / 64) * 32; it += NGW) tr_item(wdn, D_FF, 1024, (bf16_t*)wdn_dst, scr, it, 32, lane_, nullptr, 0);
    }
};
__device__ __forceinline__ void convgate_tile(const bf16_t* U, const float* cw, const float* cb, bf16_t* ACT, int pm, int pn) {
    const int lane = threadIdx.x & 63, w = threadIdx.x >> 6, cg = lane & 31, hf = lane >> 5;
    const int rs = 256 * pm + 32 * w + 16 * hf, ch = 128 * pn + 4 * cg, ucol = 256 * pn + 4 * cg;
    v4f wg[3], wv[3];
#pragma unroll
    for (int j = 0; j < 3; ++j) { wg[j] = *(const v4f*)(cw + j * UPW + ch) * -1.4426950408889634f; wv[j] = *(const v4f*)(cw + j * UPW + D_FF + ch) * -0.6931471805599453f; }
    const v4f bg = *(const v4f*)(cb + ch) * -1.4426950408889634f, bv = *(const v4f*)(cb + D_FF + ch) * -0.6931471805599453f;
    const bool seqstart = (rs % SEQ) == 0, skip2 = (w == 0) && (hf == 0) && !seqstart;
    v2u ga[18], va[18];
#pragma unroll
    for (int t = 0; t < 18; ++t) { ga[t] = (v2u){0u, 0u}; va[t] = ga[t]; }
    if (!seqstart) {
#pragma unroll
        for (int t = 0; t < 2; ++t) { ga[t] = *(const v2u*)(U + (size_t)(rs - 2 + t) * UPW + ucol); va[t] = *(const v2u*)(U + (size_t)(rs - 2 + t) * UPW + 128 + ucol); } }
#pragma unroll
    for (int t = 2; t < 18; ++t) { ga[t] = *(const v2u*)(U + (size_t)(rs - 2 + t) * UPW + ucol); va[t] = *(const v2u*)(U + (size_t)(rs - 2 + t) * UPW + 128 + ucol); }
#pragma unroll
    for (int t = 0; t < 16; ++t) {
        v4f go = bg, vo = bv;
#pragma unroll
        for (int j = 0; j < 3; ++j) { const v2u a = ga[t + j], c = va[t + j];
            go += wg[j] * (v4f){bflo(a.x), bfhi(a.x), bflo(a.y), bfhi(a.y)}; vo += wv[j] * (v4f){bflo(c.x), bfhi(c.x), bflo(c.y), bfhi(c.y)}; }
        float o[4];
#pragma unroll
        for (int e = 0; e < 4; ++e) { const float gg = go[e]; o[e] = gg * vo[e] * __builtin_amdgcn_rcpf(1.0f + __builtin_amdgcn_exp2f(gg)); }
        v2u wd; wd.x = pk2(o[0], o[1]); wd.y = pk2(o[2], o[3]);
        if (!(skip2 && t < 2)) *(v2u*)(ACT + (size_t)(rs + t) * D_FF + ch) = wd;
    }
}
__device__ __forceinline__ void convfix_item(const bf16_t* U, const float* cw, const float* cb, bf16_t* ACT, int item, int lane) {
    const int cbk = item % 11, rp = item / 11;
    const int t = rp & 1, k = rp >> 1, pm = k + 1 + (k / 31);
    const int r = 256 * pm + t, ch = cbk * 256 + 4 * lane, ucol = 256 * (ch >> 7) + (ch & 127);
    v4f go = *(const v4f*)(cb + ch), vo = *(const v4f*)(cb + D_FF + ch);
#pragma unroll
    for (int j = 0; j < 3; ++j) { const v4f wgj = *(const v4f*)(cw + j * UPW + ch), wvj = *(const v4f*)(cw + j * UPW + D_FF + ch);
        const v2u a = *(const v2u*)(U + (size_t)(r - 2 + j) * UPW + ucol), c = *(const v2u*)(U + (size_t)(r - 2 + j) * UPW + 128 + ucol);
        go += wgj * (v4f){bflo(a.x), bfhi(a.x), bflo(a.y), bfhi(a.y)}; vo += wvj * (v4f){bflo(c.x), bfhi(c.x), bflo(c.y), bfhi(c.y)}; }
    float o[4];
#pragma unroll
    for (int e = 0; e < 4; ++e) { const float gg = go[e]; o[e] = gg * __builtin_amdgcn_rcpf(1.0f + __builtin_amdgcn_exp2f(-1.4426950408889634f * gg)) * vo[e]; }
    v2u wd; wd.x = pk2(o[0], o[1]); wd.y = pk2(o[2], o[3]);
    *(v2u*)(ACT + (size_t)r * D_FF + ch) = wd;
}
struct DownOrder { pg8::StaticOrder so; const bf16_t* U; const float* cw; const float* cb; bf16_t* ACT;
    __device__ __forceinline__ bool next(int i, pg8::Unit& u) const { return so.next(i, u); }
    __device__ __forceinline__ void done(const pg8::Unit&) const {}
    __device__ __forceinline__ void a_ready(const pg8::Unit& u) const {
        if ((u.pm & 31) != 0) {
            for (int i = threadIdx.x; i < 2 * 704; i += NTHR) { const int t = i / 704, ch = 4 * (i % 704), r = 256 * u.pm + t, ucol = 256 * (ch >> 7) + (ch & 127);
                v4f go = *(const v4f*)(cb + ch), vo = *(const v4f*)(cb + D_FF + ch);
#pragma unroll
                for (int j = 0; j < 3; ++j) { const v4f wgj = *(const v4f*)(cw + j * UPW + ch), wvj = *(const v4f*)(cw + j * UPW + D_FF + ch);
                    const v2u a = *(const v2u*)(U + (size_t)(r - 2 + j) * UPW + ucol), c = *(const v2u*)(U + (size_t)(r - 2 + j) * UPW + 128 + ucol);
                    go += wgj * (v4f){bflo(a.x), bfhi(a.x), bflo(a.y), bfhi(a.y)}; vo += wvj * (v4f){bflo(c.x), bfhi(c.x), bflo(c.y), bfhi(c.y)}; }
                float o[4];
#pragma unroll
                for (int e = 0; e < 4; ++e) { const float gg = go[e]; o[e] = gg * __builtin_amdgcn_rcpf(1.0f + __builtin_amdgcn_exp2f(-1.4426950408889634f * gg)) * vo[e]; }
                v2u wd; wd.x = pk2(o[0], o[1]); wd.y = pk2(o[2], o[3]);
                *(v2u*)(ACT + (size_t)r * D_FF + ch) = wd; }
            asm volatile("s_waitcnt vmcnt(0)" ::: "memory");
        }
        __builtin_amdgcn_s_barrier();
        asm volatile("" ::: "memory");
    }
};
struct ConvOrder { pg8::StaticOrder so; const bf16_t* U; const float* cw; const float* cb; bf16_t* ACT; mutable int ppm, ppn;
    __device__ __forceinline__ bool next(int i, pg8::Unit& u) const { return so.next(i, u); }
    __device__ __forceinline__ void a_ready(const pg8::Unit&) const {}
    __device__ __forceinline__ void done(const pg8::Unit& u) const {
        if (ppm >= 0) {
            asm volatile("s_waitcnt vmcnt(48)\n\ts_barrier" ::: "memory");
            convgate_tile(U, cw, cb, ACT, ppm, ppn);
        }
        ppm = u.pm; ppn = u.pn;
    }
    __device__ __forceinline__ void flush() const {
        if (ppm >= 0) { asm volatile("s_waitcnt vmcnt(0)" ::: "memory"); __builtin_amdgcn_s_barrier(); asm volatile("" ::: "memory"); convgate_tile(U, cw, cb, ACT, ppm, ppn); ppm = -1; }
    }
};
__device__ __forceinline__ void convgate_item(const bf16_t* U, const float* cw, const float* cb, bf16_t* ACT, int item, int lane) {
    const int rb = item / 11, cbk = item % 11, r0 = rb * 32, c0 = cbk * 256 + 4 * lane;
    v4f wg[3], wv[3];
#pragma unroll
    for (int j = 0; j < 3; ++j) { wg[j] = *(const v4f*)(cw + j * UPW + c0); wv[j] = *(const v4f*)(cw + j * UPW + D_FF + c0); }
    const v4f bg = *(const v4f*)(cb + c0), bv = *(const v4f*)(cb + D_FF + c0);
    v4f g2 = {0.f, 0.f, 0.f, 0.f}, g1 = g2, v2 = g2, v1 = g2;
    if ((r0 % SEQ) != 0) {
        const v2u a = *(const v2u*)(U + (size_t)(r0 - 2) * UPW + c0), b = *(const v2u*)(U + (size_t)(r0 - 1) * UPW + c0);
        const v2u c = *(const v2u*)(U + (size_t)(r0 - 2) * UPW + D_FF + c0), d = *(const v2u*)(U + (size_t)(r0 - 1) * UPW + D_FF + c0);
        g2 = (v4f){bflo(a.x), bfhi(a.x), bflo(a.y), bfhi(a.y)}; g1 = (v4f){bflo(b.x), bfhi(b.x), bflo(b.y), bfhi(b.y)};
        v2 = (v4f){bflo(c.x), bfhi(c.x), bflo(c.y), bfhi(c.y)}; v1 = (v4f){bflo(d.x), bfhi(d.x), bflo(d.y), bfhi(d.y)};
    }
#pragma unroll
    for (int t = 0; t < 32; ++t) {
        const v2u a = *(const v2u*)(U + (size_t)(r0 + t) * UPW + c0), c = *(const v2u*)(U + (size_t)(r0 + t) * UPW + D_FF + c0);
        const v4f g0 = (v4f){bflo(a.x), bfhi(a.x), bflo(a.y), bfhi(a.y)}, v0 = (v4f){bflo(c.x), bfhi(c.x), bflo(c.y), bfhi(c.y)};
        const v4f go = bg + wg[0] * g2 + wg[1] * g1 + wg[2] * g0, vo = bv + wv[0] * v2 + wv[1] * v1 + wv[2] * v0;
        float o[4];
#pragma unroll
        for (int e = 0; e < 4; ++e) { const float gg = go[e]; o[e] = gg * __builtin_amdgcn_rcpf(1.0f + __builtin_amdgcn_exp2f(-1.4426950408889634f * gg)) * vo[e]; }
        v2u w; w.x = pk2(o[0], o[1]); w.y = pk2(o[2], o[3]);
        *(v2u*)(ACT + (size_t)(r0 + t) * D_FF + c0) = w;
        g2 = g1; g1 = g0; v2 = v1; v1 = v0;
    }
}

namespace att {
typedef short bf16x8 __attribute__((ext_vector_type(8)));
typedef short s16x4 __attribute__((ext_vector_type(4)));
typedef float f32x16 __attribute__((ext_vector_type(16)));
typedef float f32x2_t __attribute__((ext_vector_type(2)));
typedef __bf16 bf16x2_t __attribute__((ext_vector_type(2)));
__device__ __forceinline__ unsigned cvtpk(float lo, float hi) { f32x2_t v = {lo, hi}; bf16x2_t b = __builtin_convertvector(v, bf16x2_t); return __builtin_bit_cast(unsigned, b); }
__device__ __forceinline__ float fadd_s(float a, float b) { float r; asm("v_add_f32_e32 %0, %1, %2" : "=v"(r) : "v"(a), "v"(b)); return r; }
template <int C> __device__ __forceinline__ float mask_keep_c(float p, unsigned w) { unsigned t; float r;
    asm("v_bfe_i32 %0, %2, %4, 1\n\tv_and_b32_e32 %1, %0, %3" : "=&v"(t), "=v"(r) : "v"(w), "v"(p), "n"(C)); return r; }
__device__ __forceinline__ s16x4 vtr(const LAS unsigned char* p) { typedef short v4i16_t __attribute__((ext_vector_type(4))); return __builtin_bit_cast(s16x4, __builtin_amdgcn_ds_read_tr16_b64_v4i16((LAS v4i16_t*)p)); }
constexpr int VSTR = 192;
constexpr int TBL_N = 384, TBL_OFF = 320;
constexpr float LOG2E = 1.4426950408889634f;

__device__ __forceinline__ void bq_load(bf16x8 (&qr)[6], const bf16_t* SQ, size_t row, int pos, int h, int hi, const float* qg, const float* ROPE) {
    const bf16_t* qp = SQ + row * 1536 + h * 96 + 8 * hi;
    float x[6][8]; float ss = 0.f;
#pragma unroll
    for (int d0 = 0; d0 < 6; ++d0) { unpack8(*(const v4u*)(qp + 16 * d0), x[d0]);
#pragma unroll
        for (int e = 0; e < 8; ++e) ss += x[d0][e] * x[d0][e]; }
    ss += __shfl_xor(ss, 32);
    const float rn = (0.10206207261596577f * LOG2E) / sqrtf(ss * (1.0f / 96.0f) + EPS);
    const float* rp = ROPE + pos * 32 + 8 * hi;
#pragma unroll
    for (int d0 = 0; d0 < 6; ++d0) {
#pragma unroll
        for (int e = 0; e < 8; ++e) x[d0][e] = x[d0][e] * rn * qg[16 * d0 + 8 * hi + e]; }
#pragma unroll
    for (int e = 0; e < 8; ++e) { const float cs = rp[e], sn = rp[16 + e], y1 = x[4][e], y2 = x[5][e]; x[4][e] = y1 * cs - y2 * sn; x[5][e] = y1 * sn + y2 * cs; }
#pragma unroll
    for (int d0 = 0; d0 < 6; ++d0) qr[d0] = __builtin_bit_cast(bf16x8, pack8(x[d0]));
}
template <int DQK> struct Geo { static constexpr int KSTR = DQK * 2 + 16, KBUF = 64 * KSTR, VBUF = 64 * VSTR, NKC = DQK / 8, K0 = 0, V0 = 2 * KBUF, TBL = V0 + 2 * VBUF, BYTES = TBL + TBL_N * 4; };

template <int DQK, int MODE>
__device__ __forceinline__ void attn_unit(LAS unsigned char* lds, const bf16_t* __restrict__ Q, const bf16_t* __restrict__ K, const bf16_t* __restrict__ V, bf16_t* __restrict__ O,
                                          const unsigned* __restrict__ MASK, const float* __restrict__ bias, const float* __restrict__ gq, const float* __restrict__ gk, int b, int h, int qt) {
    typedef Geo<DQK> G;
    constexpr int PQ = 16 * DQK;
    const int tid = threadIdx.x, lane = tid & 63, r32 = lane & 31, hi = lane >> 5; const int wid = __builtin_amdgcn_readfirstlane(tid >> 6);
    const size_t rowbase = (size_t)b * SEQ;
    const int tq0 = qt * 256 + wid * 32;
    const int posq = tq0 + r32;
    const int cw = tq0 >> 6, lim_w = (cw + 1) * 64;
    const int j1 = 4 * qt + 3;
    int j0 = 0; if (MODE == 2) { j0 = 4 * qt - 8; if (j0 < 0) j0 = 0; }
    const int jw0 = (MODE == 2) ? (cw - 8) : 0;
    __syncthreads();
    if (MODE != 1) {
        LAS float* tbl = (LAS float*)(lds + G::TBL);
        for (int i = tid; i < TBL_N; i += NTHR) { const int rel = i - TBL_OFF; float v;
            if (MODE == 0) v = bias[t5_bucket(rel) * 16 + h];
            else { int dist = -rel; dist = dist < -63 ? -63 : (dist > 128 ? 128 : dist); v = bias[h * 192 + dist + 63]; }
            tbl[i] = v * LOG2E; }
    }
    float mref;
    { float a = fabsf(gq[lane]), c2 = fabsf(gk[lane]); if (DQK > 64 && lane < DQK - 64) { a = fmaxf(a, fabsf(gq[64 + lane])); c2 = fmaxf(c2, fabsf(gk[64 + lane])); }
#pragma unroll
      for (int o_ = 1; o_ < 64; o_ <<= 1) { a = fmaxf(a, __shfl_xor(a, o_)); c2 = fmaxf(c2, __shfl_xor(c2, o_)); }
      mref = sqrtf((float)DQK) * a * c2 * LOG2E * 1.02f + 0.5f;
      if (MODE == 0) { float mb = -1e30f; for (int i = 0; i < 32; ++i) mb = fmaxf(mb, bias[i * 16 + h]); mref += mb * LOG2E; }
      if (MODE == 2) { float mb = -1e30f; for (int i = lane; i < 192; i += 64) mb = fmaxf(mb, bias[h * 192 + i]);
#pragma unroll
          for (int o_ = 1; o_ < 64; o_ <<= 1) mb = fmaxf(mb, __shfl_xor(mb, o_));
          mref += mb * LOG2E; } }
    bf16x8 qr[DQK / 16];
    if constexpr (MODE == 1) bq_load(qr, Q, rowbase + posq, posq, h, hi, gq, bias);
    else { const bf16_t* qp = Q + (rowbase + posq) * PQ + h * DQK + 8 * hi;
#pragma unroll
        for (int d0 = 0; d0 < DQK / 16; ++d0) qr[d0] = *(const bf16x8*)(qp + 16 * d0); }
    constexpr int VP = MODE == 1 ? 2048 : 1024, VH = MODE == 1 ? 128 : 64;
    const bf16_t* Kh = K + rowbase * PQ + h * DQK; const bf16_t* Vh = V + rowbase * VP + h * VH;
    const int kc0 = tid, kc1 = tid + 512; const bool has1 = (G::NKC * 64 > 512) && (kc1 < G::NKC * 64);
    const int kr0 = kc0 / G::NKC, kp0 = kc0 % G::NKC, kr1 = kc1 / G::NKC, kp1 = kc1 % G::NKC;
    const int vr = tid >> 3, vp = tid & 7;
    v4u kreg0, kreg1 = {0u, 0u, 0u, 0u}, vreg; v2u mnext = {0u, 0u};
    const unsigned* mrow = MASK ? (MASK + (rowbase + posq) * 256) : nullptr;
#define ATT_LOAD(j) do { const size_t kv0 = (size_t)(j) * 64; \
        kreg0 = *(const v4u*)(Kh + (kv0 + kr0) * PQ + kp0 * 8); if (has1) kreg1 = *(const v4u*)(Kh + (kv0 + kr1) * PQ + kp1 * 8); \
        vreg = *(const v4u*)(Vh + (kv0 + vr) * VP + vp * 8); if (MODE == 0) mnext = *(const v2u*)(mrow + 2 * (j)); } while (0)
    ATT_LOAD(j0);
    float l = 0.f; f32x16 o[2];
#pragma unroll
    for (int i = 0; i < 16; ++i) { o[0][i] = 0.f; o[1][i] = 0.f; }
    const LAS unsigned char* kfrag = lds + G::K0 + r32 * G::KSTR + hi * 16;
    const LAS unsigned char* vfrag = lds + G::V0 + (4 * hi + ((lane & 15) >> 2)) * VSTR + (16 * ((lane >> 4) & 1) + 4 * (lane & 3)) * 2;
    for (int j = j0; j <= j1; ++j) {
        const int buf = (j - j0) & 1;
        *(LAS v4u*)(lds + G::K0 + buf * G::KBUF + kr0 * G::KSTR + kp0 * 16) = kreg0;
        if (has1) *(LAS v4u*)(lds + G::K0 + buf * G::KBUF + kr1 * G::KSTR + kp1 * 16) = kreg1;
        *(LAS v4u*)(lds + G::V0 + buf * G::VBUF + vr * VSTR + vp * 16) = vreg;
        const v2u mcur = mnext;
        __syncthreads();
        if (j < j1) ATT_LOAD(j + 1);
        const bool active = (64 * j < lim_w) && (j >= jw0);
        if (active) {
            float binit = -mref;
            bool far = false;
            if (MODE != 1) { const LAS float* tbl = (const LAS float*)(lds + G::TBL); far = (64 * j + 63 - tq0) <= -128; if (far) binit += tbl[0]; }
            f32x16 s0, s1;
#pragma unroll
            for (int i = 0; i < 16; ++i) { s0[i] = binit; s1[i] = binit; }
            const LAS unsigned char* kb = kfrag + buf * G::KBUF;
#pragma unroll
            for (int d0 = 0; d0 < DQK / 16; ++d0) {
                const bf16x8 k0 = *(const LAS bf16x8*)(kb + d0 * 32), k1 = *(const LAS bf16x8*)(kb + 32 * G::KSTR + d0 * 32);
                s0 = __builtin_amdgcn_mfma_f32_32x32x16_bf16(k0, qr[d0], s0, 0, 0, 0);
                s1 = __builtin_amdgcn_mfma_f32_32x32x16_bf16(k1, qr[d0], s1, 0, 0, 0);
            }
            if (MODE != 1 && !far) { const LAS float* tp = (const LAS float*)(lds + G::TBL) + (64 * j - posq + 4 * hi + TBL_OFF);
#pragma unroll
                for (int i = 0; i < 16; ++i) { const int c = (i & 3) + 8 * (i >> 2); s0[i] += tp[c]; s1[i] += tp[c + 32]; }
            }
#pragma unroll
            for (int i = 0; i < 16; ++i) { s0[i] = __builtin_amdgcn_exp2f(s0[i]); s1[i] = __builtin_amdgcn_exp2f(s1[i]); }
            if (MODE == 0) {
                const unsigned w0 = mcur.x >> (4 * hi), w1 = mcur.y >> (4 * hi);
                s0[0] = mask_keep_c<0>(s0[0], w0); s1[0] = mask_keep_c<0>(s1[0], w1);
                s0[1] = mask_keep_c<1>(s0[1], w0); s1[1] = mask_keep_c<1>(s1[1], w1);
                s0[2] = mask_keep_c<2>(s0[2], w0); s1[2] = mask_keep_c<2>(s1[2], w1);
                s0[3] = mask_keep_c<3>(s0[3], w0); s1[3] = mask_keep_c<3>(s1[3], w1);
                s0[4] = mask_keep_c<8>(s0[4], w0); s1[4] = mask_keep_c<8>(s1[4], w1);
                s0[5] = mask_keep_c<9>(s0[5], w0); s1[5] = mask_keep_c<9>(s1[5], w1);
                s0[6] = mask_keep_c<10>(s0[6], w0); s1[6] = mask_keep_c<10>(s1[6], w1);
                s0[7] = mask_keep_c<11>(s0[7], w0); s1[7] = mask_keep_c<11>(s1[7], w1);
                s0[8] = mask_keep_c<16>(s0[8], w0); s1[8] = mask_keep_c<16>(s1[8], w1);
                s0[9] = mask_keep_c<17>(s0[9], w0); s1[9] = mask_keep_c<17>(s1[9], w1);
                s0[10] = mask_keep_c<18>(s0[10], w0); s1[10] = mask_keep_c<18>(s1[10], w1);
                s0[11] = mask_keep_c<19>(s0[11], w0); s1[11] = mask_keep_c<19>(s1[11], w1);
                s0[12] = mask_keep_c<24>(s0[12], w0); s1[12] = mask_keep_c<24>(s1[12], w1);
                s0[13] = mask_keep_c<25>(s0[13], w0); s1[13] = mask_keep_c<25>(s1[13], w1);
                s0[14] = mask_keep_c<26>(s0[14], w0); s1[14] = mask_keep_c<26>(s1[14], w1);
                s0[15] = mask_keep_c<27>(s0[15], w0); s1[15] = mask_keep_c<27>(s1[15], w1);
            }
            { float ps0 = s0[0] + s1[0], ps1 = s0[1] + s1[1];
              asm("" : "+v"(ps0)); asm("" : "+v"(ps1));
#pragma unroll
              for (int i = 2; i < 16; i += 2) { float t0 = s0[i] + s1[i]; asm("" : "+v"(t0)); float t1 = s0[i + 1] + s1[i + 1]; asm("" : "+v"(t1));
                  ps0 += t0; asm("" : "+v"(ps0)); ps1 += t1; asm("" : "+v"(ps1)); }
              l += ps0 + ps1; }
            const LAS unsigned char* vb = vfrag + buf * G::VBUF;
#pragma unroll
            for (int blk = 0; blk < 2; ++blk)
#pragma unroll
                for (int s = 0; s < 2; ++s) {
                    v4u pw;
                    if (blk == 0) { pw.x = cvtpk(s0[8 * s + 0], s0[8 * s + 1]); pw.y = cvtpk(s0[8 * s + 2], s0[8 * s + 3]); pw.z = cvtpk(s0[8 * s + 4], s0[8 * s + 5]); pw.w = cvtpk(s0[8 * s + 6], s0[8 * s + 7]); }
                    else { pw.x = cvtpk(s1[8 * s + 0], s1[8 * s + 1]); pw.y = cvtpk(s1[8 * s + 2], s1[8 * s + 3]); pw.z = cvtpk(s1[8 * s + 4], s1[8 * s + 5]); pw.w = cvtpk(s1[8 * s + 6], s1[8 * s + 7]); }
                    const bf16x8 pf = __builtin_bit_cast(bf16x8, pw);
#pragma unroll
                    for (int dh = 0; dh < 2; ++dh) {
                        const s16x4 lo = vtr(vb + (32 * blk + 16 * s) * VSTR + dh * 64), hh = vtr(vb + (32 * blk + 16 * s + 8) * VSTR + dh * 64);
                        const bf16x8 vf = {lo[0], lo[1], lo[2], lo[3], hh[0], hh[1], hh[2], hh[3]};
                        o[dh] = __builtin_amdgcn_mfma_f32_32x32x16_bf16(vf, pf, o[dh], 0, 0, 0);
                    }
                }
        }
    }
#undef ATT_LOAD
    l += __shfl_xor(l, 32);
    const float inv = 1.0f / l;
    bf16_t* op = O + (rowbase + posq) * 1024 + h * 64 + 4 * hi;
#pragma unroll
    for (int dh = 0; dh < 2; ++dh)
#pragma unroll
        for (int g = 0; g < 4; ++g) { v2u w; w.x = cvtpk(o[dh][4 * g] * inv, o[dh][4 * g + 1] * inv); w.y = cvtpk(o[dh][4 * g + 2] * inv, o[dh][4 * g + 3] * inv);
            *(v2u*)(op + 32 * dh + 8 * g) = w; }
}
namespace pa { constexpr int NSLOT = 3, SLOTB = 8192, L_K = 0, L_V = NSLOT * SLOTB, L_WS = 2 * NSLOT * SLOTB, L_OST = L_WS + 8 * 64 * 4, L_TBL = L_OST + 8 * 4096, TBLN = 576, L_MSK = L_TBL + TBLN * 4, BYTES = L_MSK + 8 * 512; }
__device__ __forceinline__ void glds16(unsigned voff, const void* sbase, unsigned lds_dst) { unsigned keep;
    asm volatile("s_nop 4\n\ts_mov_b32 %0, m0\n\ts_mov_b32 m0, %3\n\ts_nop 0\n\tglobal_load_lds_dwordx4 %1, %2\n\ts_mov_b32 m0, %0" : "=&s"(keep) : "v"(voff), "s"(sbase), "s"(lds_dst) : "memory"); }
__device__ __forceinline__ void glds4(unsigned voff, const void* sbase, unsigned lds_dst) { unsigned keep;
    asm volatile("s_nop 4\n\ts_mov_b32 %0, m0\n\ts_mov_b32 m0, %3\n\ts_nop 0\n\tglobal_load_lds_dword %1, %2\n\ts_mov_b32 m0, %0" : "=&s"(keep) : "v"(voff), "s"(sbase), "s"(lds_dst) : "memory"); }
__device__ __forceinline__ void attn_unit_a(LAS unsigned char* lds, const bf16_t* Q, const bf16_t* K, const bf16_t* V, bf16_t* O, const unsigned* MASK, const float* bias, const float* gq, const float* gk, int b, int h, int qt) {
    using namespace pa;
    const int tid = threadIdx.x, lane = tid & 63, r32 = lane & 31, hi = lane >> 5; const int wid = __builtin_amdgcn_readfirstlane(tid >> 6);
    const size_t rowbase = (size_t)b * SEQ; const int q0 = qt * 256, tq0 = q0 + wid * 32, posq = tq0 + r32;
    const int cw = tq0 >> 6;
    const int NT = 4 * qt + 4;
    asm volatile("s_waitcnt lgkmcnt(0)\n\ts_barrier" ::: "memory");
    const float bfar = bias[t5_bucket(-TBL_OFF) * 16 + h] * LOG2E;
    { LAS float* tbl = (LAS float*)(lds + L_TBL);
      for (int i = tid; i < TBLN; i += NTHR) tbl[i] = bias[t5_bucket(i - TBL_OFF) * 16 + h] * LOG2E - bfar; }
    const f32x16 zc = {0.f, 0.f, 0.f, 0.f, 0.f, 0.f, 0.f, 0.f, 0.f, 0.f, 0.f, 0.f, 0.f, 0.f, 0.f, 0.f};
    const bf16_t* Kh = K + rowbase * 1024 + h * 64; const bf16_t* Vh = V + rowbase * 1024 + h * 64;
    const unsigned lds0 = (unsigned)(size_t)lds;
    const unsigned koff = (unsigned)(lane * 1024 + wid * 8) * 2u;
    const unsigned voff = (unsigned)((16 * (wid & 3) + (lane >> 2)) * 1024 + (wid >> 2) * 32 + (lane & 3) * 8) * 2u;
    const unsigned kdst = lds0 + L_K + wid * 1024, vdst = lds0 + L_V + wid * 1024;
    const unsigned* mbase = MASK + rowbase * 256; const unsigned moff = (unsigned)(tq0 + r32) * 1024u + 4u * (unsigned)hi; const unsigned mdst = lds0 + L_MSK + wid * 512;
    const LAS unsigned* mrd = (const LAS unsigned*)(lds + L_MSK + wid * 512) + r32;
#define DMA_K(t, slot) glds16(koff, (const char*)Kh + (size_t)(t) * 131072, (unsigned)__builtin_amdgcn_readfirstlane(kdst + (slot)))
#define DMA_V(t, slot) glds16(voff, (const char*)Vh + (size_t)(t) * 131072, (unsigned)__builtin_amdgcn_readfirstlane(vdst + (slot)))
#define MDMA(t) glds4(moff, mbase + 2 * (t), (unsigned)__builtin_amdgcn_readfirstlane(mdst + ((t) & 1) * 256))
#define SBAR() __builtin_amdgcn_sched_barrier(0)
#define PIN(x) asm volatile("" : "+v"(x))
#define WAIT_BAR(N) asm volatile("s_waitcnt vmcnt(" #N ") lgkmcnt(0)\n\ts_barrier" : : : "memory")
    const LAS unsigned char* kp0 = lds + L_K + hi * 1024 + r32 * 16;
    const LAS unsigned char* vp0 = lds + L_V + ((lane >> 4) & 1) * 32 + (lane & 3) * 8 + (4 * hi + ((lane & 15) >> 2)) * 64;
    LAS float* wsf = (LAS float*)(lds + L_WS) + wid * 64;
    const LAS float* tbl0 = (const LAS float*)(lds + L_TBL) + (4 * hi + TBL_OFF - posq);
    DMA_K(0, 0); DMA_V(0, 0); DMA_K(1, SLOTB);
    bf16x8 qr[4];
    { const bf16_t* qp = Q + (rowbase + posq) * 1024 + h * 64 + 8 * hi;
#pragma unroll
      for (int d0 = 0; d0 < 4; ++d0) qr[d0] = *(const bf16x8*)(qp + 16 * d0); }
    DMA_K(2, 2 * SLOTB); MDMA(0);
    float l_reg = 0.f; f32x16 o[2];
#pragma unroll
    for (int i = 0; i < 16; ++i) { o[0][i] = 0.f; o[1][i] = 0.f; }
    bf16x8 kf[8];
    f32x16 pA0, pA1, pB0, pB1;
    int sl_prev = 0, sl_cur = 0, sl_next = SLOTB;
#define ROT() do { sl_prev = sl_cur; sl_cur = sl_next; sl_next = (sl_next == (NSLOT - 1) * SLOTB) ? 0 : sl_next + SLOTB; } while (0)
#define KF(p) (*(const LAS bf16x8*)(p))
#define ADDBIAS(C0, C1, t) do { const LAS float* tp_ = tbl0 + 64 * (t); _Pragma("unroll") for (int r = 0; r < 16; ++r) { const int c_ = (r & 3) + 8 * (r >> 2); C0[r] += tp_[c_]; C1[r] += tp_[c_ + 32]; } } while (0)
    WAIT_BAR(4);
    { const LAS unsigned char* kb = kp0;
#pragma unroll
      for (int d0 = 0; d0 < 4; ++d0) { const bf16x8 b0 = KF(kb + d0 * 2048), b1 = KF(kb + d0 * 2048 + 512);
          if (d0 == 0) { pA0 = __builtin_amdgcn_mfma_f32_32x32x16_bf16(b0, qr[0], zc, 0, 0, 0); pA1 = __builtin_amdgcn_mfma_f32_32x32x16_bf16(b1, qr[0], zc, 0, 0, 0); }
          else { pA0 = __builtin_amdgcn_mfma_f32_32x32x16_bf16(b0, qr[d0], pA0, 0, 0, 0); pA1 = __builtin_amdgcn_mfma_f32_32x32x16_bf16(b1, qr[d0], pA1, 0, 0, 0); } }
      if (63 - tq0 > -128) ADDBIAS(pA0, pA1, 0);
#pragma unroll
      for (int r = 0; r < 16; ++r) { pA0[r] = __builtin_amdgcn_exp2f(pA0[r]); pA1[r] = __builtin_amdgcn_exp2f(pA1[r]); } }
    WAIT_BAR(0);
    DMA_K(3, 0); DMA_V(1, SLOTB); MDMA(1);
    ROT();
#pragma unroll
    for (int j = 0; j < 4; ++j) { kf[2 * j] = KF(kp0 + sl_cur + j * 2048); kf[2 * j + 1] = KF(kp0 + sl_cur + j * 2048 + 512); }
    WAIT_BAR(3);
    s16x4 vlo[8], vhi[8]; v4u pw0, pw1, pw2, pw3;
#define PAF(k) __builtin_bit_cast(bf16x8, pw##k)
#define VFR(i) (bf16x8){vlo[i][0], vlo[i][1], vlo[i][2], vlo[i][3], vhi[i][0], vhi[i][1], vhi[i][2], vhi[i][3]}
#define MFMA(a, b, c) __builtin_amdgcn_mfma_f32_32x32x16_bf16(a, b, c, 0, 0, 0)
#define MK4(X, B, w) do { X[B] = mask_keep_c<2 * (B)>(X[B], w); X[B + 1] = mask_keep_c<2 * (B) + 1>(X[B + 1], w); X[B + 2] = mask_keep_c<2 * (B) + 2>(X[B + 2], w); X[B + 3] = mask_keep_c<2 * (B) + 3>(X[B + 3], w); } while (0)
#define GAPA(MF, X, B, w, PW, H) do { MF; MK4(X, B, w); sacc0 += X[B]; sacc1 += X[B + 1]; sacc0 += X[B + 2]; sacc1 += X[B + 3]; PIN(sacc0); PIN(sacc1); \
        PW[2 * (H)] = cvtpk(X[B], X[B + 1]); PW[2 * (H) + 1] = cvtpk(X[B + 2], X[B + 3]); PIN(PW); SBAR(); } while (0)
#define EX(v) __builtin_amdgcn_exp2f(v)
#define GAPB(MF, X, B) do { MF; X[B] = EX(X[B]); X[B + 1] = EX(X[B + 1]); X[B + 2] = EX(X[B + 2]); X[B + 3] = EX(X[B + 3]); PIN(X); SBAR(); } while (0)
#define VRD(i) do { vlo[i] = vtr(vp_ + (((i) >> 2) * 4096 + ((i) & 3) * 1024)); vhi[i] = vtr(vp_ + (((i) >> 2) * 4096 + ((i) & 3) * 1024 + 512)); } while (0)
#define KRD(G, j) do { if (G) { kf[2 * (j)] = KF(kp0 + sl_next + (j) * 2048); kf[2 * (j) + 1] = KF(kp0 + sl_next + (j) * 2048 + 512); SBAR(); } } while (0)
#define STEP(C0, C1, P0, P1, t, GK, GV, GL, PEEL) do { SBAR(); \
        const LAS unsigned char* vp_ = vp0 + sl_prev; \
        v2u mu_; mu_.x = mrd[(((t) - 1) & 1) * 64]; mu_.y = mrd[(((t) - 1) & 1) * 64 + 32]; if (PEEL) { if ((t) - 1 > cw) { mu_.x = 0u; mu_.y = 0u; } } \
        const unsigned w0_ = mu_.x >> (4 * hi), w1_ = mu_.y >> (4 * hi); float sacc0 = 0.f, sacc1 = 0.f; \
        VRD(0); SBAR(); GAPA(C0 = MFMA(kf[0], qr[0], zc), P0, 0, w0_, pw0, 0); \
        VRD(4); SBAR(); GAPA(C1 = MFMA(kf[1], qr[0], zc), P0, 4, w0_, pw0, 1); \
        VRD(1); SBAR(); GAPA(C0 = MFMA(kf[2], qr[1], C0), P0, 8, w0_, pw1, 0); \
        VRD(5); SBAR(); GAPA(C1 = MFMA(kf[3], qr[1], C1), P0, 12, w0_, pw1, 1); \
        VRD(2); SBAR(); GAPA(C0 = MFMA(kf[4], qr[2], C0), P1, 0, w1_, pw2, 0); \
        VRD(6); SBAR(); GAPA(C1 = MFMA(kf[5], qr[2], C1), P1, 4, w1_, pw2, 1); \
        VRD(3); SBAR(); GAPA(C0 = MFMA(kf[6], qr[3], C0), P1, 8, w1_, pw3, 0); \
        VRD(7); SBAR(); GAPA(C1 = MFMA(kf[7], qr[3], C1), P1, 12, w1_, pw3, 1); \
        l_reg += sacc0 + sacc1; \
        if (GK) { DMA_K((t) + 3, sl_cur); } if (GV) { DMA_V((t) + 1, sl_next); MDMA((t) + 1); } \
        if (PEEL) { if (64 * (t) + 63 - tq0 > -128) ADDBIAS(C0, C1, t); } \
        SBAR(); \
        GAPB(o[0] = MFMA(PAF(0), VFR(0), o[0]), C0, 0); \
        GAPB(o[1] = MFMA(PAF(0), VFR(4), o[1]), C0, 4); \
        KRD(GL, 0); GAPB(o[0] = MFMA(PAF(1), VFR(1), o[0]), C0, 8); \
        KRD(GL, 1); GAPB(o[1] = MFMA(PAF(1), VFR(5), o[1]), C0, 12); \
        KRD(GL, 2); GAPB(o[0] = MFMA(PAF(2), VFR(2), o[0]), C1, 0); \
        KRD(GL, 3); GAPB(o[1] = MFMA(PAF(2), VFR(6), o[1]), C1, 4); \
        GAPB(o[0] = MFMA(PAF(3), VFR(3), o[0]), C1, 8); \
        GAPB(o[1] = MFMA(PAF(3), VFR(7), o[1]), C1, 12); \
    } while (0)
    int t = 1;
    for (; t + 7 < NT; t += 2) {
        STEP(pB0, pB1, pA0, pA1, t, true, true, true, false);     WAIT_BAR(3); ROT();
        STEP(pA0, pA1, pB0, pB1, t + 1, true, true, true, false); WAIT_BAR(3); ROT();
    }
#define ENDW(tt) do { if ((tt) + 3 < NT) { WAIT_BAR(3); } else if ((tt) + 2 < NT) { WAIT_BAR(2); } else { WAIT_BAR(0); } } while (0)
    for (; t + 1 < NT; t += 2) {
        STEP(pB0, pB1, pA0, pA1, t, (t + 3 < NT), (t + 1 < NT), (t + 1 < NT), true);     ENDW(t);     ROT();
        STEP(pA0, pA1, pB0, pB1, t + 1, (t + 4 < NT), (t + 2 < NT), (t + 2 < NT), true); ENDW(t + 1); ROT();
    }
    STEP(pB0, pB1, pA0, pA1, NT - 1, false, false, false, true);
    { v2u mu_; mu_.x = mrd[64]; mu_.y = mrd[64 + 32]; if (NT - 1 > cw) { mu_.x = 0u; mu_.y = 0u; }
      const unsigned w0_ = mu_.x >> (4 * hi), w1_ = mu_.y >> (4 * hi);
      MK4(pB0, 0, w0_); MK4(pB0, 4, w0_); MK4(pB0, 8, w0_); MK4(pB0, 12, w0_); MK4(pB1, 0, w1_); MK4(pB1, 4, w1_); MK4(pB1, 8, w1_); MK4(pB1, 12, w1_);
      float sacc = 0.f;
#pragma unroll
      for (int r = 0; r < 16; ++r) sacc += pB0[r] + pB1[r];
      l_reg += sacc;
      pw0 = (v4u){cvtpk(pB0[0], pB0[1]), cvtpk(pB0[2], pB0[3]), cvtpk(pB0[4], pB0[5]), cvtpk(pB0[6], pB0[7])};
      pw1 = (v4u){cvtpk(pB0[8], pB0[9]), cvtpk(pB0[10], pB0[11]), cvtpk(pB0[12], pB0[13]), cvtpk(pB0[14], pB0[15])};
      pw2 = (v4u){cvtpk(pB1[0], pB1[1]), cvtpk(pB1[2], pB1[3]), cvtpk(pB1[4], pB1[5]), cvtpk(pB1[6], pB1[7])};
      pw3 = (v4u){cvtpk(pB1[8], pB1[9]), cvtpk(pB1[10], pB1[11]), cvtpk(pB1[12], pB1[13]), cvtpk(pB1[14], pB1[15])};
      const LAS unsigned char* vp_ = vp0 + sl_cur;
#pragma unroll
      for (int i = 0; i < 8; ++i) { vlo[i] = vtr(vp_ + ((i >> 2) * 4096 + (i & 3) * 1024)); vhi[i] = vtr(vp_ + ((i >> 2) * 4096 + (i & 3) * 1024 + 512)); }
      o[0] = MFMA(PAF(0), VFR(0), o[0]); o[1] = MFMA(PAF(0), VFR(4), o[1]); o[0] = MFMA(PAF(1), VFR(1), o[0]); o[1] = MFMA(PAF(1), VFR(5), o[1]);
      o[0] = MFMA(PAF(2), VFR(2), o[0]); o[1] = MFMA(PAF(2), VFR(6), o[1]); o[0] = MFMA(PAF(3), VFR(3), o[0]); o[1] = MFMA(PAF(3), VFR(7), o[1]); }
    { const unsigned lu = __float_as_uint(l_reg); auto rr = __builtin_amdgcn_permlane32_swap(lu, lu, false, false); l_reg = __uint_as_float(rr[0]) + __uint_as_float(rr[1]); }
    if (hi == 0) wsf[32 + r32] = l_reg;
    asm volatile("s_waitcnt lgkmcnt(0)" : : : "memory");
    float rli[16];
#pragma unroll
    for (int r = 0; r < 16; ++r) rli[r] = __builtin_amdgcn_rcpf(wsf[32 + (r & 3) + 8 * (r >> 2) + 4 * hi]);
    bf16_t* Ow = O + (rowbase + q0 + wid * 32) * 1024 + h * 64;
    { LAS bf16_t* stg = (LAS bf16_t*)(lds + L_OST) + wid * 2048;
#pragma unroll
      for (int r = 0; r < 16; ++r) { const int orow = (r & 3) + 8 * (r >> 2) + 4 * hi;
#pragma unroll
          for (int d0 = 0; d0 < 2; ++d0) stg[orow * 64 + d0 * 32 + r32] = (bf16_t)cvtpk(o[d0][r] * rli[r], 0.f); }
      asm volatile("s_waitcnt lgkmcnt(0)" : : : "memory");
#pragma unroll
      for (int i = 0; i < 4; ++i) { const int row = i * 8 + (lane >> 3), ch = lane & 7; const v4u v = *(const LAS v4u*)(stg + row * 64 + ch * 8); *(v4u*)(Ow + (size_t)row * 1024 + ch * 8) = v; } }
    asm volatile("s_waitcnt lgkmcnt(0)\n\ts_barrier" : : : "memory");
#undef DMA_K
#undef DMA_V
#undef MDMA
#undef SBAR
#undef PIN
#undef WAIT_BAR
#undef ROT
#undef KF
#undef ADDBIAS
#undef PAF
#undef VFR
#undef MFMA
#undef MK4
#undef GAPA
#undef EX
#undef GAPB
#undef VRD
#undef KRD
#undef STEP
#undef ENDW
}
namespace pb { constexpr int NSLOT = 3, KSLOT = 12288, VSLOT = 8192, L_K = 0, L_V = 4 * KSLOT, L_WS = L_V + NSLOT * VSLOT, L_OST = L_WS + 8 * 64 * 4, BYTES = L_OST + 8 * 4096; }
__device__ __forceinline__ void attn_unit_b(LAS unsigned char* lds, const bf16_t* Q, const bf16_t* K, const bf16_t* V, bf16_t* O, const float* gq, const float* rope, int b, int h, int qt) {
    using namespace pb;
    const int tid = threadIdx.x, lane = tid & 63, r32 = lane & 31, hi = lane >> 5; const int wid = __builtin_amdgcn_readfirstlane(tid >> 6);
    const size_t rowbase = (size_t)b * SEQ; const int q0 = qt * 256, tq0 = q0 + wid * 32, posq = tq0 + r32;
    const int cw = tq0 >> 6;
    const int NT = 4 * qt + 4;
    asm volatile("s_waitcnt lgkmcnt(0)\n\ts_barrier" ::: "memory");
    const f32x16 zc = {0.f, 0.f, 0.f, 0.f, 0.f, 0.f, 0.f, 0.f, 0.f, 0.f, 0.f, 0.f, 0.f, 0.f, 0.f, 0.f};
    const bf16_t* Kh = K + rowbase * 1536 + h * 96; const bf16_t* Vh = V + rowbase * 2048 + h * 128;
    const unsigned lds0 = (unsigned)(size_t)lds;
    const unsigned koffA = (unsigned)(lane * 1536 + wid * 8) * 2u, koffB = (unsigned)(lane * 1536 + (8 + (wid & 3)) * 8) * 2u;
    const unsigned voff = (unsigned)((16 * (wid & 3) + (lane >> 2)) * 2048 + (wid >> 2) * 32 + (lane & 3) * 8) * 2u;
    const unsigned kdstA = lds0 + L_K + wid * 1024, kdstB = lds0 + L_K + (8 + (wid & 3)) * 1024, vdst = lds0 + L_V + wid * 1024;
#define RFL(x) ((unsigned)__builtin_amdgcn_readfirstlane(x))
#define DMA_K(t, sl) do { const char* kb_ = (const char*)Kh + (size_t)(t) * (64 * 1536 * 2); glds16(koffA, kb_, RFL(kdstA + (sl) * KSLOT)); glds16(koffB, kb_, RFL(kdstB + (sl) * KSLOT)); } while (0)
#define DMA_V(t, sl) glds16(voff, (const char*)Vh + (size_t)(t) * 262144, RFL(vdst + (sl) * VSLOT))
#define SBAR() __builtin_amdgcn_sched_barrier(0)
#define PIN(x) asm volatile("" : "+v"(x))
#define WAIT_BAR(N) asm volatile("s_waitcnt vmcnt(" #N ") lgkmcnt(0)\n\ts_barrier" : : : "memory")
    const LAS unsigned char* kp0 = lds + L_K + hi * 1024 + r32 * 16;
    const LAS unsigned char* vp0 = lds + L_V + ((lane >> 4) & 1) * 32 + (lane & 3) * 8 + (4 * hi + ((lane & 15) >> 2)) * 64;
    LAS float* wsf = (LAS float*)(lds + L_WS) + wid * 64;
    DMA_K(0, 0); DMA_V(0, 0); DMA_K(1, 1);
    bf16x8 qr[6];
    bq_load(qr, Q, rowbase + posq, posq, h, hi, gq, rope);
    DMA_K(2, 2);
    float l_reg = 0.f; f32x16 o[2];
#pragma unroll
    for (int i = 0; i < 16; ++i) { o[0][i] = 0.f; o[1][i] = 0.f; }
    bf16x8 kf[12];
    f32x16 pA0, pA1, pB0, pB1;
    int ks = 0, sl_prev = 0, sl_cur = 0, sl_next = 1;
#define ROT() do { ks = (ks + 1) & 3; sl_prev = sl_cur; sl_cur = sl_next; sl_next = (sl_next == NSLOT - 1) ? 0 : sl_next + 1; } while (0)
#define KF(p) (*(const LAS bf16x8*)(p))
#define MFMA(a, b, c) __builtin_amdgcn_mfma_f32_32x32x16_bf16(a, b, c, 0, 0, 0)
    WAIT_BAR(5);
    { const LAS unsigned char* kb = kp0;
#pragma unroll
      for (int d0 = 0; d0 < 6; ++d0) { const bf16x8 b0 = KF(kb + d0 * 2048), b1 = KF(kb + d0 * 2048 + 512);
          if (d0 == 0) { pA0 = MFMA(b0, qr[0], zc); pA1 = MFMA(b1, qr[0], zc); } else { pA0 = MFMA(b0, qr[d0], pA0); pA1 = MFMA(b1, qr[d0], pA1); } }
#pragma unroll
      for (int r = 0; r < 16; ++r) { pA0[r] = __builtin_amdgcn_exp2f(pA0[r]); pA1[r] = __builtin_amdgcn_exp2f(pA1[r]); } }
    WAIT_BAR(0);
    DMA_K(3, 3); DMA_V(1, 1);
    ROT();
#pragma unroll
    for (int j = 0; j < 4; ++j) { kf[2 * j] = KF(kp0 + ks * KSLOT + j * 2048); kf[2 * j + 1] = KF(kp0 + ks * KSLOT + j * 2048 + 512); }
    WAIT_BAR(3);
    s16x4 vlo[8], vhi[8]; v4u pw0, pw1, pw2, pw3;
#define PAF(k) __builtin_bit_cast(bf16x8, pw##k)
#define VFR(i) (bf16x8){vlo[i][0], vlo[i][1], vlo[i][2], vlo[i][3], vhi[i][0], vhi[i][1], vhi[i][2], vhi[i][3]}
#define GAPA(MF, X, B, PW, H) do { MF; sacc0 += X[B]; sacc1 += X[B + 1]; sacc0 += X[B + 2]; sacc1 += X[B + 3]; PIN(sacc0); PIN(sacc1); \
        PW[2 * (H)] = cvtpk(X[B], X[B + 1]); PW[2 * (H) + 1] = cvtpk(X[B + 2], X[B + 3]); PIN(PW); SBAR(); } while (0)
#define EX(v) __builtin_amdgcn_exp2f(v)
#define VRD(i) do { vlo[i] = vtr(vp_ + (((i) >> 2) * 4096 + ((i) & 3) * 1024)); vhi[i] = vtr(vp_ + (((i) >> 2) * 4096 + ((i) & 3) * 1024 + 512)); } while (0)
#define KRD(G, j) do { if (G) { kf[2 * (j)] = KF(kp0 + ((ks + 1) & 3) * KSLOT + (j) * 2048); kf[2 * (j) + 1] = KF(kp0 + ((ks + 1) & 3) * KSLOT + (j) * 2048 + 512); } } while (0)
#define KR2(j) do { kf[2 * (j)] = KF(kp0 + ks * KSLOT + (j) * 2048); kf[2 * (j) + 1] = KF(kp0 + ks * KSLOT + (j) * 2048 + 512); } while (0)
#define GAPB(PRE, MF, X, B) do { PRE; SBAR(); MF; X[B] = EX(X[B]); X[B + 1] = EX(X[B + 1]); X[B + 2] = EX(X[B + 2]); X[B + 3] = EX(X[B + 3]); PIN(X); SBAR(); } while (0)
#define STEP(C0, C1, P0, P1, t, GK, GV, GL, PEEL) do { SBAR(); \
        const LAS unsigned char* vp_ = vp0 + sl_prev * VSLOT; \
        if (PEEL) { if ((t) - 1 > cw) { _Pragma("unroll") for (int r = 0; r < 16; ++r) { P0[r] = 0.f; P1[r] = 0.f; } } } \
        float sacc0 = 0.f, sacc1 = 0.f; \
        VRD(0); SBAR(); GAPA(C0 = MFMA(kf[0], qr[0], zc), P0, 0, pw0, 0); \
        VRD(4); SBAR(); GAPA(C1 = MFMA(kf[1], qr[0], zc), P0, 4, pw0, 1); \
        VRD(1); SBAR(); GAPA(C0 = MFMA(kf[2], qr[1], C0), P0, 8, pw1, 0); \
        VRD(5); SBAR(); GAPA(C1 = MFMA(kf[3], qr[1], C1), P0, 12, pw1, 1); \
        KR2(4); SBAR(); GAPA(C0 = MFMA(kf[4], qr[2], C0), P1, 0, pw2, 0); \
        KR2(5); SBAR(); GAPA(C1 = MFMA(kf[5], qr[2], C1), P1, 4, pw2, 1); \
        GAPA(C0 = MFMA(kf[6], qr[3], C0), P1, 8, pw3, 0); \
        GAPA(C1 = MFMA(kf[7], qr[3], C1), P1, 12, pw3, 1); \
        l_reg += sacc0 + sacc1; \
        VRD(2); SBAR(); C0 = MFMA(kf[8], qr[4], C0); SBAR(); \
        VRD(6); SBAR(); C1 = MFMA(kf[9], qr[4], C1); SBAR(); \
        VRD(3); SBAR(); C0 = MFMA(kf[10], qr[5], C0); SBAR(); \
        VRD(7); SBAR(); C1 = MFMA(kf[11], qr[5], C1); SBAR(); \
        if (GK) { DMA_K((t) + 3, (ks + 3) & 3); } if (GV) { DMA_V((t) + 1, sl_next); } \
        SBAR(); \
        GAPB((void)0, o[0] = MFMA(PAF(0), VFR(0), o[0]), C0, 0); \
        GAPB(KRD(GL, 0), o[1] = MFMA(PAF(0), VFR(4), o[1]), C0, 4); \
        GAPB(KRD(GL, 1), o[0] = MFMA(PAF(1), VFR(1), o[0]), C0, 8); \
        GAPB(KRD(GL, 2), o[1] = MFMA(PAF(1), VFR(5), o[1]), C0, 12); \
        GAPB(KRD(GL, 3), o[0] = MFMA(PAF(2), VFR(2), o[0]), C1, 0); \
        GAPB((void)0, o[1] = MFMA(PAF(2), VFR(6), o[1]), C1, 4); \
        GAPB((void)0, o[0] = MFMA(PAF(3), VFR(3), o[0]), C1, 8); \
        GAPB((void)0, o[1] = MFMA(PAF(3), VFR(7), o[1]), C1, 12); \
    } while (0)
    int t = 1;
    for (; t + 5 < NT; t += 2) {
        STEP(pB0, pB1, pA0, pA1, t, true, true, true, false);     WAIT_BAR(3); ROT();
        STEP(pA0, pA1, pB0, pB1, t + 1, true, true, true, false); WAIT_BAR(3); ROT();
    }
#define ENDW(tt) do { if ((tt) + 3 < NT) { WAIT_BAR(3); } else if ((tt) + 2 < NT) { WAIT_BAR(1); } else { WAIT_BAR(0); } } while (0)
    for (; t + 1 < NT; t += 2) {
        STEP(pB0, pB1, pA0, pA1, t, (t + 3 < NT), (t + 1 < NT), (t + 1 < NT), true);     ENDW(t);     ROT();
        STEP(pA0, pA1, pB0, pB1, t + 1, (t + 4 < NT), (t + 2 < NT), (t + 2 < NT), true); ENDW(t + 1); ROT();
    }
    STEP(pB0, pB1, pA0, pA1, NT - 1, false, false, false, true);
    { if (NT - 1 > cw) {
#pragma unroll
          for (int r = 0; r < 16; ++r) { pB0[r] = 0.f; pB1[r] = 0.f; } }
      float sacc = 0.f;
#pragma unroll
      for (int r = 0; r < 16; ++r) sacc += pB0[r] + pB1[r];
      l_reg += sacc;
      pw0 = (v4u){cvtpk(pB0[0], pB0[1]), cvtpk(pB0[2], pB0[3]), cvtpk(pB0[4], pB0[5]), cvtpk(pB0[6], pB0[7])};
      pw1 = (v4u){cvtpk(pB0[8], pB0[9]), cvtpk(pB0[10], pB0[11]), cvtpk(pB0[12], pB0[13]), cvtpk(pB0[14], pB0[15])};
      pw2 = (v4u){cvtpk(pB1[0], pB1[1]), cvtpk(pB1[2], pB1[3]), cvtpk(pB1[4], pB1[5]), cvtpk(pB1[6], pB1[7])};
      pw3 = (v4u){cvtpk(pB1[8], pB1[9]), cvtpk(pB1[10], pB1[11]), cvtpk(pB1[12], pB1[13]), cvtpk(pB1[14], pB1[15])};
      const LAS unsigned char* vp_ = vp0 + sl_cur * VSLOT;
      s16x4 dlo[8], dhi[8];
#pragma unroll
      for (int f = 0; f < 8; ++f) { dlo[f] = vtr(vp_ + ((f >> 2) * 4096 + (f & 3) * 1024)); dhi[f] = vtr(vp_ + ((f >> 2) * 4096 + (f & 3) * 1024 + 512)); }
#define DFR(f) (bf16x8){dlo[f][0], dlo[f][1], dlo[f][2], dlo[f][3], dhi[f][0], dhi[f][1], dhi[f][2], dhi[f][3]}
      o[0] = MFMA(PAF(0), DFR(0), o[0]); o[1] = MFMA(PAF(0), DFR(4), o[1]); o[0] = MFMA(PAF(1), DFR(1), o[0]); o[1] = MFMA(PAF(1), DFR(5), o[1]);
      o[0] = MFMA(PAF(2), DFR(2), o[0]); o[1] = MFMA(PAF(2), DFR(6), o[1]); o[0] = MFMA(PAF(3), DFR(3), o[0]); o[1] = MFMA(PAF(3), DFR(7), o[1]);
#undef DFR
    }
    { const unsigned lu = __float_as_uint(l_reg); auto rr = __builtin_amdgcn_permlane32_swap(lu, lu, false, false); l_reg = __uint_as_float(rr[0]) + __uint_as_float(rr[1]); }
    if (hi == 0) wsf[32 + r32] = l_reg;
    asm volatile("s_waitcnt lgkmcnt(0)" : : : "memory");
    float rli[16];
#pragma unroll
    for (int r = 0; r < 16; ++r) rli[r] = __builtin_amdgcn_rcpf(wsf[32 + (r & 3) + 8 * (r >> 2) + 4 * hi]);
    bf16_t* Ow = O + (rowbase + q0 + wid * 32) * 1024 + h * 64;
    { LAS bf16_t* stg = (LAS bf16_t*)(lds + L_OST) + wid * 2048;
#pragma unroll
      for (int r = 0; r < 16; ++r) { const int orow = (r & 3) + 8 * (r >> 2) + 4 * hi;
#pragma unroll
          for (int d0 = 0; d0 < 2; ++d0) stg[orow * 64 + d0 * 32 + r32] = (bf16_t)cvtpk(o[d0][r] * rli[r], 0.f); }
      asm volatile("s_waitcnt lgkmcnt(0)" : : : "memory");
#pragma unroll
      for (int i = 0; i < 4; ++i) { const int row = i * 8 + (lane >> 3), ch = lane & 7; const v4u v = *(const LAS v4u*)(stg + row * 64 + ch * 8); *(v4u*)(Ow + (size_t)row * 1024 + ch * 8) = v; } }
    asm volatile("s_waitcnt lgkmcnt(0)\n\ts_barrier" : : : "memory");
#undef RFL
#undef DMA_K
#undef DMA_V
#undef SBAR
#undef PIN
#undef WAIT_BAR
#undef ROT
#undef KF
#undef MFMA
#undef PAF
#undef VFR
#undef GAPA
#undef EX
#undef VRD
#undef KRD
#undef GAPB
#undef STEP
#undef ENDW
}
__device__ __forceinline__ bool b_fast(const float* gq, const float* gk, int lane) {
    float a = fabsf(gq[lane]), c2 = fabsf(gk[lane]); if (lane < 32) { a = fmaxf(a, fabsf(gq[64 + lane])); c2 = fmaxf(c2, fabsf(gk[64 + lane])); }
#pragma unroll
    for (int o_ = 1; o_ < 64; o_ <<= 1) { a = fmaxf(a, __shfl_xor(a, o_)); c2 = fmaxf(c2, __shfl_xor(c2, o_)); }
    return 9.7979589711f * a * c2 * LOG2E * 1.02f < 100.0f;
}
__device__ __forceinline__ bool a_fast(const float* bias, const float* gq, const float* gk, int lane) {
    float a = fabsf(gq[lane]), c2 = fabsf(gk[lane]), mb = 0.f;
#pragma unroll
    for (int i = 0; i < 8; ++i) mb = fmaxf(mb, fabsf(bias[lane + 64 * i]));
#pragma unroll
    for (int o_ = 1; o_ < 64; o_ <<= 1) { a = fmaxf(a, __shfl_xor(a, o_)); c2 = fmaxf(c2, __shfl_xor(c2, o_)); mb = fmaxf(mb, __shfl_xor(mb, o_)); }
    return 8.0f * a * c2 * LOG2E * 1.02f + 2.0f * mb * LOG2E < 100.0f;
}
template <int DQK, int MODE, class Pre>
__device__ __forceinline__ void attn_phase(LAS unsigned char* lds, const bf16_t* Q, const bf16_t* K, const bf16_t* V, bf16_t* O, const unsigned* MASK, const float* bias, const float* gq, const float* gk, int vcu, int G_, const Pre& pre) {
    bool fast = false;
    if (MODE == 0) fast = a_fast(bias, gq, gk, (int)(threadIdx.x & 63)); else if (MODE == 1) fast = b_fast(gq, gk, (int)(threadIdx.x & 63));
    for (int u = vcu; u < 1024; u += G_) {
        const int g = u & 255, k = u >> 8;
        pre(k);
        const int p = g & 15, bh = 2 * (g >> 4) + (k >> 1), qt = (k & 1) ? (31 - p) : p;
        if (MODE == 0 && fast) attn_unit_a(lds, Q, K, V, O, MASK, bias, gq, gk, bh >> 4, bh & 15, qt);
        else if (MODE == 1 && fast) attn_unit_b(lds, Q, K, V, O, gq, bias, bh >> 4, bh & 15, qt);
        else attn_unit<DQK, MODE>(lds, Q, K, V, O, MASK, bias, gq, gk, bh >> 4, bh & 15, qt);
    }
}
}
namespace idx {
typedef short bf16x8 __attribute__((ext_vector_type(8)));
typedef float f32x16 __attribute__((ext_vector_type(16)));
typedef int v4i __attribute__((ext_vector_type(4)));
constexpr int LCAP = 512;
constexpr int OFF_DUMMY = 65536, OFF_RES = 65536 + 256, OFF_CNT = OFF_RES + 64, OFF_RED = OFF_RES + 128, OFF_LIST = 65536 + 1024, OFF_QF = OFF_LIST + 4 * LCAP * 8;
__device__ __forceinline__ float relu(float x) { return __builtin_amdgcn_fmed3f(x, 0.0f, __builtin_inff()); }

__device__ __forceinline__ int wave_prefix_incl(int v) {
    v += __builtin_amdgcn_update_dpp(0, v, 0x111, 0xf, 0xf, false);
    v += __builtin_amdgcn_update_dpp(0, v, 0x112, 0xf, 0xf, false);
    v += __builtin_amdgcn_update_dpp(0, v, 0x114, 0xf, 0xf, false);
    v += __builtin_amdgcn_update_dpp(0, v, 0x118, 0xf, 0xf, false);
    v += __builtin_amdgcn_update_dpp(0, v, 0x142, 0xa, 0xf, false);
    v += __builtin_amdgcn_update_dpp(0, v, 0x143, 0xc, 0xf, false);
    return v;
}
__device__ __forceinline__ void idx_unit(LAS unsigned char* lds, const bf16_t* __restrict__ QI, const bf16_t* __restrict__ KI, const float* __restrict__ WI, unsigned* __restrict__ MASK, int b, int c, int sub, int par, bool has_next, int nb, int nc, int nsub) {
    int tid_ = threadIdx.x; asm volatile("" : "+v"(tid_));
    const int tid = tid_, lane = tid & 63, hi = lane >> 5, n = lane & 31; const int wid = __builtin_amdgcn_readfirstlane(tid >> 6);
    const size_t rowbase = (size_t)b * SEQ; const int row0 = c * 64 + 4 * sub;
    const int ntiles = 2 * (c + 1);
#define IDX_STAGE_NEXT(t_) do { const int r_ = (t_) >> 3, pc_ = (t_) & 7; \
        *(LAS v4u*)(lds + OFF_QF + (par ^ 1) * 4608 + r_ * 144 + pc_ * 16) = *(const v4u*)(QI + ((size_t)nb * SEQ + nc * 64 + 4 * nsub + (r_ >> 3)) * 512 + (r_ & 7) * 64 + pc_ * 8); } while (0)
    unsigned* mrow0 = MASK + (rowbase + row0 + 2 * hi) * 256;
    if (ntiles <= 8) {
        if (n == 0) { for (int T = wid; T < ntiles; T += 8) { mrow0[T] = 0xffffffffu; mrow0[256 + T] = 0xffffffffu; } }
        if (has_next) { if (tid < 256) IDX_STAGE_NEXT(tid); __syncthreads(); }
        return;
    }
    const unsigned dummy = (unsigned)OFF_DUMMY + 4u * (unsigned)lane;
    const unsigned qb0 = (unsigned)(2 * hi) * 16384u, qb1 = qb0 + 16384u;
    const LAS unsigned char* qfp = lds + OFF_QF + par * 4608 + n * 144 + hi * 16;
    float wr[16];
#pragma unroll
    for (int i = 0; i < 16; ++i) wr[i] = WI[(rowbase + row0 + (i >> 2)) * 8 + (i & 3) + 4 * hi] * (0.125f * 0.35355339059327373f);
    const bf16_t* kp = KI + rowbase * 64 + 8 * lane;
    const int np = (ntiles + 15) >> 4;
    const int rot = (5 * sub + 3 * b + c) % np;
    unsigned key[32][2];
    bf16x8 kf[2][2][4];
#define IDX_PR(kk) ((kk) + rot - (((kk) + rot >= np) ? np : 0))
#define IDX_LOAD(buf, kk) do { const int pr_ = IDX_PR(kk); _Pragma("unroll") for (int u_ = 0; u_ < 2; ++u_) { int T_ = 8 * (2 * pr_ + u_) + wid; T_ = T_ < ntiles ? T_ : ntiles - 1; const bf16_t* kt_ = kp + (size_t)T_ * 2048; \
        _Pragma("unroll") for (int s_ = 0; s_ < 4; ++s_) kf[buf][u_][s_] = *(const bf16x8*)(kt_ + 512 * s_); } } while (0)
    IDX_LOAD(0, 0);
#pragma unroll
    for (int kk = 0; kk < 16; ++kk) {
        key[2 * kk][0] = 0u; key[2 * kk][1] = 0u; key[2 * kk + 1][0] = 0u; key[2 * kk + 1][1] = 0u;
        if (kk < np) {
            const int pr = IDX_PR(kk);
            f32x16 acc[2];
#pragma unroll
            for (int i = 0; i < 16; ++i) { acc[0][i] = 0.f; acc[1][i] = 0.f; }
            if (kk + 1 < 16) { if (kk + 1 < np) IDX_LOAD((kk + 1) & 1, kk + 1); }
#pragma unroll
            for (int s = 0; s < 4; ++s) { const bf16x8 qf = *(const LAS bf16x8*)(qfp + 32 * s);
                                          acc[0] = __builtin_amdgcn_mfma_f32_32x32x16_bf16(qf, kf[kk & 1][0][s], acc[0], 0, 0, 0);
                                          acc[1] = __builtin_amdgcn_mfma_f32_32x32x16_bf16(qf, kf[kk & 1][1][s], acc[1], 0, 0, 0); }
#pragma unroll
            for (int u = 0; u < 2; ++u) {
                const bool valid = 8 * (2 * pr + u) + wid < ntiles;
                float p[4];
#pragma unroll
                for (int q = 0; q < 4; ++q) { float a = relu(acc[u][4 * q]) * wr[4 * q];
#pragma unroll
                    for (int j = 1; j < 4; ++j) a += relu(acc[u][4 * q + j]) * wr[4 * q + j];
                    p[q] = a; }
#pragma unroll
                for (int e = 0; e < 2; ++e) {
                    const auto rr = __builtin_amdgcn_permlane32_swap(__float_as_uint(p[e]), __float_as_uint(p[2 + e]), false, false);
                    const unsigned kv = valid ? fkey(__uint_as_float(rr[0]) + __uint_as_float(rr[1]) + 0.0f) : 0u;
                    key[2 * kk + u][e] = kv;
                    __hip_atomic_fetch_add((LAS unsigned*)(lds + (valid ? ((e ? qb1 : qb0) + 4u * (kv >> 20)) : dummy)), 1u, __ATOMIC_RELAXED, __HIP_MEMORY_SCOPE_WORKGROUP);
                }
            }
        }
    }
#undef IDX_LOAD
    LAS unsigned* H = (LAS unsigned*)lds;
    volatile LAS int* res = (volatile LAS int*)(lds + OFF_RES);
    LAS unsigned* lcnt = (LAS unsigned*)(lds + OFF_CNT);
    __syncthreads();
    if (wid < 4) {
        const int q = wid; const LAS unsigned* Hq = H + q * 4096; const int grp = 63 - lane;
        unsigned sg = 0u;
#pragma unroll 4
        for (int i = 0; i < 16; ++i) { const v4u t = *(const LAS v4u*)(Hq + 64 * grp + 4 * ((i + lane) & 15)); sg += (t.x + t.y) + (t.z + t.w); }
        const int pre = wave_prefix_incl((int)sg);
        const int need = 256;
        const int l1 = 64 - __popcll(__ballot(pre >= need));
        const int js = 63 - l1;
        const int above_c = __builtin_amdgcn_readlane(pre - (int)sg, l1);
        const unsigned f = Hq[64 * js + 63 - lane];
        const int pre2 = wave_prefix_incl((int)f);
        const int l2 = 64 - __popcll(__ballot(above_c + pre2 >= need));
        const int ls = 63 - l2;
        const int above = above_c + __builtin_amdgcn_readlane(pre2 - (int)f, l2);
        const int cnt = __builtin_amdgcn_readlane((int)f, l2);
        if (lane == 0) { res[q * 4 + 0] = (64 * js + ls) << 20; res[q * 4 + 1] = need - above; res[q * 4 + 2] = cnt; }
    }
    __syncthreads();
    const unsigned d0 = (unsigned)res[(2 * hi) * 4] >> 20, d1 = (unsigned)res[(2 * hi + 1) * 4] >> 20;
    const bool overflow = res[2] > LCAP || res[6] > LCAP || res[10] > LCAP || res[14] > LCAP;
    unsigned Tq0, Tq1; int J0, J1;
    if (!overflow) {
        LAS v2u* list = (LAS v2u*)(lds + OFF_LIST);
#pragma unroll
        for (int k = 0; k < 32; ++k) {
            const int pr = IDX_PR(k >> 1); const unsigned kidx = 32u * (unsigned)(8 * (2 * pr + (k & 1)) + wid) + (unsigned)n;
#pragma unroll
            for (int e = 0; e < 2; ++e) { const unsigned kv = key[k][e];
                if ((kv >> 20) == (e ? d1 : d0)) { const unsigned pos = __hip_atomic_fetch_add(lcnt + 2 * hi + e, 1u, __ATOMIC_RELAXED, __HIP_MEMORY_SCOPE_WORKGROUP);
                    if (pos < (unsigned)LCAP) list[(2 * hi + e) * LCAP + pos] = (v2u){kv, kidx}; } }
        }
        __syncthreads();
        if (wid < 4) {
            const int q = wid; const int L = res[q * 4 + 2], need = res[q * 4 + 1];
            unsigned ck[LCAP / 64], ci[LCAP / 64];
#pragma unroll
            for (int i = 0; i < LCAP / 64; ++i) { ck[i] = 0u; ci[i] = 0xffffffffu; if (i * 64 < L) { if (i * 64 + lane < L) { const v2u t = list[q * LCAP + i * 64 + lane]; ck[i] = t.x; ci[i] = t.y; } } }
            unsigned T = (unsigned)res[q * 4 + 0];
            if (L <= 64) {
                const unsigned k0 = ck[0];
                for (int sh = 16; sh >= 0; sh -= 4) { int dsel = 0;
#pragma unroll
                    for (int d = 1; d < 16; ++d) dsel += (__popcll(__ballot(k0 >= (T | ((unsigned)d << sh)))) >= need) ? 1 : 0;
                    T |= (unsigned)dsel << sh; }
            } else
            for (int bit = 19; bit >= 0; --bit) {
                const unsigned cand = T | (1u << bit); int cnt = 0;
#pragma unroll
                for (int i = 0; i < LCAP / 64; ++i) if (i * 64 < L) cnt += __popcll(__ballot(ck[i] >= cand));
                if (cnt >= need) T = cand;
            }
            int cgt = 0, ceq = 0;
#pragma unroll
            for (int i = 0; i < LCAP / 64; ++i) if (i * 64 < L) { cgt += __popcll(__ballot(ck[i] > T)); ceq += __popcll(__ballot(ck[i] == T)); }
            const int neq = need - cgt;
            int J = SEQ;
            if (neq < ceq) { int Jb = 0;
                for (int bit = 13; bit >= 0; --bit) { const unsigned cj = (unsigned)(Jb | (1 << bit)); int cnt = 0;
#pragma unroll
                    for (int i = 0; i < LCAP / 64; ++i) if (i * 64 < L) cnt += __popcll(__ballot(ck[i] == T && ci[i] < cj));
                    if (cnt < neq) Jb = (int)cj; }
                J = Jb + 1; }
            if (lane == 0) { res[q * 4 + 0] = (int)T; res[q * 4 + 1] = J; }
        } else {
            v4u qn_ = {0u, 0u, 0u, 0u}; const int t_ = tid - 256, r_ = t_ >> 3, pc_ = t_ & 7;
            if (has_next) qn_ = *(const v4u*)(QI + ((size_t)nb * SEQ + nc * 64 + 4 * nsub + (r_ >> 3)) * 512 + (r_ & 7) * 64 + pc_ * 8);
            for (int i = tid - 256; i < 4096; i += 256) ((LAS v4u*)lds)[i] = (v4u){0u, 0u, 0u, 0u};
            if (has_next) *(LAS v4u*)(lds + OFF_QF + (par ^ 1) * 4608 + r_ * 144 + pc_ * 16) = qn_;
        }
        __syncthreads();
        Tq0 = (unsigned)res[(2 * hi) * 4]; Tq1 = (unsigned)res[(2 * hi + 1) * 4]; J0 = res[(2 * hi) * 4 + 1]; J1 = res[(2 * hi + 1) * 4 + 1];
    } else {
        unsigned pre0 = d0 << 20, pre1 = d1 << 20;
#pragma unroll
        for (int pass = 1; pass < 3; ++pass) {
            const int sh = pass == 1 ? 8 : 0; const unsigned dm = pass == 1 ? 0xfffu : 0xffu;
            __syncthreads();
            for (int i = tid; i < 4096; i += NTHR) ((LAS v4u*)lds)[i] = (v4u){0u, 0u, 0u, 0u};
            __syncthreads();
#pragma unroll
            for (int k = 0; k < 32; ++k)
#pragma unroll
                for (int e = 0; e < 2; ++e) { const unsigned kv = key[k][e], pre = e ? pre1 : pre0;
                    const bool ok = pass == 1 ? ((kv >> 20) == (pre >> 20)) : ((kv >> 8) == (pre >> 8));
                    const unsigned addr = ok ? ((e ? qb1 : qb0) + 4u * ((kv >> sh) & dm)) : dummy;
                    __hip_atomic_fetch_add((LAS unsigned*)(lds + addr), 1u, __ATOMIC_RELAXED, __HIP_MEMORY_SCOPE_WORKGROUP); }
            __syncthreads();
            if (wid < 4) {
                const int q = wid; const LAS unsigned* Hq = H + q * 4096;
                unsigned sg = 0u;
#pragma unroll
                for (int i = 0; i < 16; ++i) { const v4u t = *(const LAS v4u*)(Hq + 64 * lane + 4 * i); sg += (t.x + t.y) + (t.z + t.w); }
                int suf = (int)sg;
#pragma unroll
                for (int o = 1; o < 64; o <<= 1) { const int t = __shfl_down(suf, o); if (lane + o < 64) suf += t; }
                const int need = res[q * 4 + 1];
                const int js = __popcll(__ballot(suf >= need)) - 1;
                const int above_c = __shfl(suf - (int)sg, js);
                const unsigned f = Hq[64 * js + lane];
                int suf2 = (int)f;
#pragma unroll
                for (int o = 1; o < 64; o <<= 1) { const int t = __shfl_down(suf2, o); if (lane + o < 64) suf2 += t; }
                const int ls = __popcll(__ballot(above_c + suf2 >= need)) - 1;
                const int above = above_c + __shfl(suf2 - (int)f, ls);
                const int cnt = __shfl((int)f, ls);
                if (lane == 0) { res[q * 4 + 0] = res[q * 4 + 0] | ((64 * js + ls) << sh); res[q * 4 + 1] = need - above; res[q * 4 + 2] = cnt; }
            }
            __syncthreads();
            pre0 = (unsigned)res[(2 * hi) * 4]; pre1 = (unsigned)res[(2 * hi + 1) * 4];
        }
        Tq0 = pre0; Tq1 = pre1;
        volatile LAS v4i* red = (volatile LAS v4i*)(lds + OFF_RED);
        const int needa = res[(2 * hi) * 4 + 1], needb = res[(2 * hi + 1) * 4 + 1];
        int Jb0 = 0, Jb1 = 0;
        for (int bit = 13; bit >= 0; --bit) {
            const int cj0 = Jb0 | (1 << bit), cj1 = Jb1 | (1 << bit);
            int n0 = 0, n1 = 0, n2 = 0, n3 = 0;
#pragma unroll
            for (int k = 0; k < 32; ++k) { const int pr = IDX_PR(k >> 1); const int kidx = 32 * (8 * (2 * pr + (k & 1)) + wid) + n;
                const unsigned long long m0 = __ballot(key[k][0] == Tq0 && kidx < cj0), m1 = __ballot(key[k][1] == Tq1 && kidx < cj1);
                n0 += __popc((unsigned)m0); n2 += __popc((unsigned)(m0 >> 32)); n1 += __popc((unsigned)m1); n3 += __popc((unsigned)(m1 >> 32)); }
            __syncthreads();
            if (lane == 0) red[wid] = (v4i){n0, n1, n2, n3};
            __syncthreads();
            v4i tot = red[0];
#pragma unroll
            for (int w = 1; w < 8; ++w) { const v4i t = red[w]; tot += t; }
            if ((hi ? tot[2] : tot[0]) < needa) Jb0 = cj0;
            if ((hi ? tot[3] : tot[1]) < needb) Jb1 = cj1;
        }
        J0 = Jb0 + 1; J1 = Jb1 + 1;
        for (int i = tid; i < 4096; i += NTHR) ((LAS v4u*)lds)[i] = (v4u){0u, 0u, 0u, 0u};
        if (has_next && tid < 256) IDX_STAGE_NEXT(tid);
        __syncthreads();
    }
    if (tid < 4) ((LAS unsigned*)(lds + OFF_CNT))[tid] = 0u;
    const bool notie = __all(J0 == SEQ && J1 == SEQ) != 0;
    unsigned w0 = 0u, w1 = 0u;
#define IDX_WL(w, val, ln) asm("v_writelane_b32 %0, %1, %2" : "+v"(w) : "s"(val), "n"(ln))
#pragma unroll
    for (int k = 0; k < 32; ++k) {
        const int pr = IDX_PR(k >> 1); const int T = 8 * (2 * pr + (k & 1)) + wid;
        if ((k >> 1) < np && T < ntiles) {
            const int kidx = 32 * T + n;
            unsigned long long m0, m1;
            if (notie) { m0 = __ballot(key[k][0] >= Tq0); m1 = __ballot(key[k][1] >= Tq1); }
            else { m0 = __ballot(key[k][0] > Tq0 || (key[k][0] == Tq0 && kidx < J0)); m1 = __ballot(key[k][1] > Tq1 || (key[k][1] == Tq1 && kidx < J1)); }
            IDX_WL(w0, (unsigned)m0, k); IDX_WL(w0, (unsigned)(m0 >> 32), 32 + k); IDX_WL(w1, (unsigned)m1, k); IDX_WL(w1, (unsigned)(m1 >> 32), 32 + k);
            __builtin_amdgcn_sched_barrier(0);
        }
    }
    { const int kk = n >> 1, pr = IDX_PR(kk), T = 8 * (2 * pr + (n & 1)) + wid;
      if (kk < np && T < ntiles) { mrow0[T] = w0; mrow0[256 + T] = w1; } }
#undef IDX_WL
#undef IDX_PR
#undef IDX_STAGE_NEXT
}
__device__ __forceinline__ void idx_phase(LAS unsigned char* lds, const bf16_t* QI, const bf16_t* KI, const float* WI, unsigned* MASK, int vcu, int G_) {
    const int g = vcu & 255;
    for (int i = threadIdx.x; i < 4096; i += NTHR) ((LAS v4u*)lds)[i] = (v4u){0u, 0u, 0u, 0u};
    if (threadIdx.x < 4) ((LAS unsigned*)(lds + OFF_CNT))[threadIdx.x] = 0u;
    if (vcu < 4096 && threadIdx.x < 256) { const int r0_ = g; const int b0_ = (r0_ >> 4) & 1, c0_ = 127 - (r0_ >> 5), s0_ = r0_ & 15; const int r_ = threadIdx.x >> 3, pc_ = threadIdx.x & 7;
        *(LAS v4u*)(lds + OFF_QF + r_ * 144 + pc_ * 16) = *(const v4u*)(QI + ((size_t)b0_ * SEQ + c0_ * 64 + 4 * s0_ + (r_ >> 3)) * 512 + (r_ & 7) * 64 + pc_ * 8); }
    __syncthreads();
    for (int u = vcu; u < 4096; u += G_) {
        const int k = u >> 8;
        const int pos = (k & 1) ? (255 - g) : g, r = 256 * k + pos;
        const bool has_next = u + G_ < 4096; const int k1 = k + 1, pos1 = (k1 & 1) ? (255 - g) : g, r1 = 256 * k1 + pos1;
        idx_unit(lds, QI, KI, WI, MASK, (r >> 4) & 1, 127 - (r >> 5), r & 15, k & 1, has_next, (r1 >> 4) & 1, 127 - (r1 >> 5), r1 & 15);
    }
}
}
constexpr size_t MiB = 1u << 20;
constexpr size_t WS_CTL = 0, CTL_ZERO_BYTES = 1 * MiB;
constexpr size_t WS_ROPE = 1 * MiB;
constexpr size_t WS_SSQ = 2 * MiB;
constexpr size_t WS_W = 10 * MiB;
constexpr size_t W_IN = 0, W_OUT = 15 * MiB / 2, W_UP = 19 * MiB / 2, W_DN = 41 * MiB / 2, W_UQ = 26 * MiB, W_UKV = 26 * MiB + 3 * MiB / 4;
constexpr size_t WS_H = 38 * MiB;
constexpr size_t WS_BIG = 70 * MiB;
constexpr size_t WS_END = WS_BIG + 272 * MiB;
constexpr size_t B_SCRB = 0, B_Q = 120 * MiB, B_K = 152 * MiB, B_V = 184 * MiB, B_QI = 216 * MiB, B_KI = 232 * MiB, B_WI = 234 * MiB, B_MASK = 235 * MiB, B_O = 0;
constexpr size_t BB_CQN = 16 * MiB, BB_CKVN = 24 * MiB, BB_KR = 28 * MiB, BB_SCRQ = 32 * MiB, BB_SCRKV = 80 * MiB, BB_QB = 144 * MiB, BB_KB = 192 * MiB, BB_VB = 240 * MiB, BB_O = 144 * MiB;
constexpr size_t B_U = 0, B_ACT = 176 * MiB;
constexpr int CW_BAR = 4096;
constexpr int MAX_LAUNCH = 16;
static_assert((CW_BAR + MAX_LAUNCH * XCD_BAR_WORDS) * 4 <= (int)CTL_ZERO_BYTES, "barrier regions inside the memset region");
constexpr int RING_BYTES = 131072, LDSCTL_OFF = RING_BYTES, MISC_OFF = LDSCTL_OFF + 320, LDS_BYTES = 147456;
constexpr int NPH = 13;

struct Args { const float* in[26]; float* out; unsigned char* ws; int ph_lo, ph_hi, li, pad, rep, pad2; };

struct Ctx { LAS unsigned char* lds; const Args* a; unsigned char* ws; int lo, hi, lane, wave, vcu, G, gw, NGW; bool first; };

template <int L>
__device__ __forceinline__ void prep_mixer(const Args& args, unsigned char* wreg, LAS float* scr, int iw, int NIW, int lane) {
    constexpr int kind = L % 3, jj = L / 3;
    const float* gmix = args.in[1] + (size_t)L * D_MODEL;
#define CONV(src, dst, K_, N_, Np_, g_, hc_) do { const int nblk_ = (Np_) / 32, nit_ = ((K_) / 64) * nblk_; for (int it = iw; it < nit_; it += NIW) tr_item((src), (K_), (N_), (bf16_t*)(dst), scr, it, nblk_, lane, (g_), (hc_)); } while (0)
    if (kind == 0) { CONV(args.in[4] + (size_t)jj * D_MODEL * A_IN, wreg + W_IN, 1024, A_IN, A_INP, gmix, 2048); CONV(args.in[8] + (size_t)jj * 1024 * 1024, wreg + W_OUT, 1024, 1024, 1024, nullptr, 0); }
    else if (kind == 1) { CONV(args.in[9], wreg + W_IN, 1024, B_DOWN, B_DOWNP, gmix, 0); CONV(args.in[12], wreg + W_UQ, 256, 1536, 1536, nullptr, 0); CONV(args.in[13], wreg + W_UKV, 128, 2048, 2048, nullptr, 0); CONV(args.in[16], wreg + W_OUT, 1024, 1024, 1024, nullptr, 0); }
    else { CONV(args.in[17], wreg + W_IN, 1024, 3072, 3072, gmix, 2048); CONV(args.in[21], wreg + W_OUT, 1024, 1024, 1024, nullptr, 0); }
#undef CONV
}
#define SEAM() do { if (!c.first) xcd_barrier(bar); c.first = false; } while (0)
template <int LAYER>
__device__ __forceinline__ void run_layer(Ctx& c, const XcdBarrier& bar) {
    constexpr int kind = LAYER % 3, jj = LAYER / 3;
    const Args& args = *c.a;
    LAS unsigned char* lds = c.lds;
    const int lane = c.lane, gw = c.gw, NGW = c.NGW, G_ = c.G, vcu = c.vcu;
    float* X = args.out;
    const float* xsrc = LAYER == 0 ? args.in[0] : X;
    unsigned char* ws = c.ws;
    float* ROPE = (float*)(ws + WS_ROPE);
    bf16_t* Hb = (bf16_t*)(ws + WS_H);
    float* SSQ = (float*)(ws + WS_SSQ) + (size_t)(2 * LAYER) * M_TOK * 16;
    unsigned char* big = ws + WS_BIG; unsigned char* wreg = ws + WS_W;
#define RUN(k) (c.lo <= LAYER * NPH + (k) && LAYER * NPH + (k) < c.hi)
    if (LAYER == 0 && RUN(0)) { SEAM();
      {
        LAS float* scr = (LAS float*)(lds + c.wave * 16384);
        prep_mixer<0>(args, wreg, scr, gw, NGW, lane);
        for (int m = gw; m < M_TOK; m += 4 * NGW) xb_rows4(xsrc, Hb, SSQ, m, NGW, lane);
        rope_fill(ROPE, gw, NGW, lane);
      }
    }
    if (RUN(1)) { SEAM();
      {
        constexpr int N = kind == 0 ? A_INP : (kind == 1 ? B_DOWNP : 3072);
        pg8::Gemm g{Hb, (const bf16_t*)(wreg + W_IN), M_TOK, N, 1024}; pg8::StaticOrder S; S.init(M_TOK, N, G_, (int)blockIdx.x);
        if constexpr (kind == 1) { pg8::EpiStore E{(bf16_t*)(big + B_SCRB), N, SSQ}; pg8::gemm_phase<pg8::EpiStore, pg8::StaticOrder, true, true>(lds, g, S, E); }
        else {
            pg8::EpiInAC E{(bf16_t*)(big + B_Q), (bf16_t*)(big + B_K), (bf16_t*)(big + B_V), (bf16_t*)(big + B_SCRB), 768, 4, SSQ,
                           kind == 0 ? args.in[5] + jj * 64 : args.in[18], kind == 0 ? args.in[6] + jj * 64 : args.in[19]};
            if constexpr (kind == 0) {
                static_assert(IDX_OFF_SI == B_SCRB && IDX_OFF_QI == B_QI && IDX_OFF_KI == B_KI && IDX_OFF_WI == B_WI, "workspace map");
                IdxOrder SI_; SI_.so = S; SI_.big = big; SI_.kig = args.in[7] + jj * 64; SI_.ROPE = ROPE; SI_.first = 12;
                pg8::gemm_phase<pg8::EpiInAC, IdxOrder, true, true>(lds, g, SI_, E); }
            else pg8::gemm_phase<pg8::EpiInAC, pg8::StaticOrder, true, true>(lds, g, S, E); }
        if (kind != 2) {
            constexpr int extra = ((M_TOK / 256) * (N / 256)) % 256;
            if (G_ == 256 && (int)blockIdx.x >= extra) { __syncthreads();
                FfnConv fc{args.in[22] + (size_t)LAYER * D_MODEL * UPW, args.in[25] + (size_t)LAYER * D_FF * 1024, args.in[2] + (size_t)LAYER * D_MODEL, wreg + W_UP, wreg + W_DN, lds, ((int)blockIdx.x - extra) * NWAVES + c.wave, (256 - extra) * NWAVES, lane, c.wave, 0};
                fc(0); }
        }
      }
    }
    if (kind == 1 && RUN(2)) { SEAM();
      {
        {
            for (int m = gw; m < M_TOK; m += 8 * NGW) post_b1_rows<8>((const bf16_t*)(big + B_SCRB), m, NGW, args.in[10], args.in[11], (bf16_t*)(big + BB_CQN), (bf16_t*)(big + BB_CKVN), (float*)(big + BB_KR), lane); }
      }
    }
    if (kind == 1 && RUN(3)) { SEAM();
      {
        pg8::Gemm g{(const bf16_t*)(big + BB_CQN), (const bf16_t*)(wreg + W_UQ), M_TOK, 1536, 256 + args.pad}; pg8::StaticOrder S; S.init(M_TOK, 1536, G_, (int)blockIdx.x);
        pg8::EpiStore E{(bf16_t*)(big + BB_SCRQ), 1536, nullptr};
        pg8::gemm_phase<pg8::EpiStore, pg8::StaticOrder, true, true>(lds, g, S, E);
      }
    }
    if (kind == 1 && RUN(4)) { if (!RUN(3)) SEAM(); else __syncthreads();
      {
        pg8::Gemm g{(const bf16_t*)(big + BB_CKVN), (const bf16_t*)(wreg + W_UKV), M_TOK, 2048, 128 + args.pad};
        KOrder S; S.so.init(M_TOK, 2048, G_, (int)blockIdx.x); S.SKV = (const bf16_t*)(big + BB_SCRKV); S.KRB = (const float*)(big + BB_KR); S.kg = args.in[15]; S.ROPE = ROPE; S.KB = (bf16_t*)(big + BB_KB);
        pg8::EpiStore E{(bf16_t*)(big + BB_SCRKV), 2048, nullptr};
        pg8::gemm_phase<pg8::EpiStore, KOrder, true, true>(lds, g, S, E);
      }
    }
    if (kind == 0 && RUN(6)) { SEAM();
      {
        idx::idx_phase(lds, (const bf16_t*)(big + B_QI), (const bf16_t*)(big + B_KI), (const float*)(big + B_WI), (unsigned*)(big + B_MASK), vcu, G_);
      }
    }
    if (RUN(7)) { SEAM();
      {
        FfnConv pre{args.in[22] + (size_t)LAYER * D_MODEL * UPW, args.in[25] + (size_t)LAYER * D_FF * 1024, args.in[2] + (size_t)LAYER * D_MODEL, wreg + W_UP, wreg + W_DN, lds, gw, NGW, lane, c.wave, (kind == 2 || G_ != 256) ? (vcu & 3) : -1};
        if (kind == 0) att::attn_phase<64, 0>(lds, (const bf16_t*)(big + B_Q), (const bf16_t*)(big + B_K), (const bf16_t*)(big + B_V), (bf16_t*)(big + B_O), (const unsigned*)(big + B_MASK), args.in[3], args.in[5] + jj * 64, args.in[6] + jj * 64, vcu, G_, pre);
        else if (kind == 1) att::attn_phase<96, 1>(lds, (const bf16_t*)(big + BB_SCRQ), (const bf16_t*)(big + BB_KB), (const bf16_t*)(big + BB_SCRKV) + 64, (bf16_t*)(big + BB_O), nullptr, ROPE, args.in[14], args.in[15], vcu, G_, pre);
        else att::attn_phase<64, 2>(lds, (const bf16_t*)(big + B_Q), (const bf16_t*)(big + B_K), (const bf16_t*)(big + B_V), (bf16_t*)(big + B_O), nullptr, args.in[20], args.in[18], args.in[19], vcu, G_, pre);
      }
    }
    if (RUN(8)) { SEAM();
        pg8::Gemm g{(const bf16_t*)(big + (kind == 1 ? BB_O : B_O)), (const bf16_t*)(wreg + W_OUT), M_TOK, 1024, 1024}; pg8::StaticOrder S; S.init(M_TOK, 1024, G_, (int)blockIdx.x);
        pg8::EpiResidB E{Hb, SSQ + (size_t)M_TOK * 16, nullptr, 1024, true};
        pg8::gemm_phase<pg8::EpiResidB, pg8::StaticOrder, true, true>(lds, g, S, E);
    }
    if (RUN(10)) { SEAM();
      {
        pg8::Gemm g{Hb, (const bf16_t*)(wreg + W_UP), M_TOK, UPW, 1024};
        ConvOrder S; S.so.init(M_TOK, UPW, G_, (int)blockIdx.x); S.U = (const bf16_t*)(big + B_U); S.cw = args.in[23] + (size_t)LAYER * 3 * UPW; S.cb = args.in[24] + (size_t)LAYER * UPW; S.ACT = (bf16_t*)(big + B_ACT); S.ppm = -1; S.ppn = 0;
        pg8::EpiStore E{(bf16_t*)(big + B_U), UPW, SSQ + (size_t)M_TOK * 16};
        pg8::gemm_phase<pg8::EpiStore, ConvOrder, true, true>(lds, g, S, E);
        S.flush();
        if (LAYER + 1 < DEPTH) {
            const int extra = (M_TOK / 256) * (UPW / 256) % G_;
            if (extra > 0 && (int)blockIdx.x >= extra) { __syncthreads();
                int iw_ = ((int)blockIdx.x - extra) * NWAVES + c.wave, lane_ = lane; asm volatile("" : "+v"(lane_)); asm volatile("" : "+s"(iw_));
                prep_mixer<(LAYER + 1 < DEPTH ? LAYER + 1 : 0)>(args, wreg, (LAS float*)(lds + c.wave * 16384), iw_, (G_ - extra) * NWAVES, lane_); }
        }
      }
    }
    if (RUN(12)) { SEAM();
        pg8::Gemm g{(const bf16_t*)(big + B_ACT), (const bf16_t*)(wreg + W_DN), M_TOK, 1024, D_FF};
        DownOrder S; S.so.init(M_TOK, 1024, G_, (int)blockIdx.x); S.U = (const bf16_t*)(big + B_U); S.cw = args.in[23] + (size_t)LAYER * 3 * UPW; S.cb = args.in[24] + (size_t)LAYER * UPW; S.ACT = (bf16_t*)(big + B_ACT);
        pg8::EpiResidB E{Hb, LAYER < DEPTH - 1 ? SSQ + (size_t)2 * M_TOK * 16 : nullptr, LAYER == DEPTH - 1 ? X : nullptr, 1024, LAYER < DEPTH - 1};
        pg8::gemm_phase<pg8::EpiResidB, DownOrder, true, true>(lds, g, S, E);
    }
#undef RUN
}
#undef SEAM

__global__ void __launch_bounds__(NTHR, 2) mega(Args args) {
    extern __shared__ __attribute__((aligned(16))) unsigned char lds_raw[];
    LAS unsigned char* lds = (LAS unsigned char*)lds_raw;
    volatile LAS unsigned* MISC = (volatile LAS unsigned*)(lds + MISC_OFF);
    const int tid = threadIdx.x;
    Ctx c; c.lds = lds; c.a = &args; c.ws = args.ws; c.lo = args.ph_lo; c.hi = args.ph_hi; c.lane = tid & 63; c.wave = __builtin_amdgcn_readfirstlane(tid >> 6);
    c.G = gridDim.x; { const int bx = blockIdx.x; c.vcu = (c.G % 8 == 0) ? (bx % 8) * (c.G / 8) + bx / 8 : bx; }
    c.gw = c.vcu * NWAVES + c.wave; c.NGW = c.G * NWAVES; c.first = true;
    for (int u = tid; u < (LDS_BYTES - LDSCTL_OFF) / 4; u += NTHR) ((LAS unsigned*)(lds + LDSCTL_OFF))[u] = 0u;
    __syncthreads();
    const XcdBarrier bar = xcd_barrier_post((unsigned*)(args.ws + WS_CTL) + CW_BAR + args.li * XCD_BAR_WORDS, MISC + 8);
    run_layer<0>(c, bar); run_layer<1>(c, bar); run_layer<2>(c, bar); run_layer<3>(c, bar);
}
extern "C" void kernel_launch(void* const* d_in, const int* in_sizes, int n_in, void* d_out, int out_size, void* d_ws, size_t ws_size, hipStream_t stream) {
    static int grid = 0;
    if (grid == 0) {
        if (n_in != 26 || out_size != M_TOK * D_MODEL || ws_size < WS_END) { fprintf(stderr, "kernel_launch: unexpected sizes: n_in %d out %d ws %zu (need %zu); nothing launched\n", n_in, out_size, ws_size, (size_t)WS_END); grid = -1; return; }
        int dev = 0, cus = 0, per_cu = 0;
        if (hipGetDevice(&dev) != hipSuccess || hipDeviceGetAttribute(&cus, hipDeviceAttributeMultiprocessorCount, dev) != hipSuccess) { grid = -1; return; }
        if (hipFuncSetAttribute((const void*)mega, hipFuncAttributeMaxDynamicSharedMemorySize, LDS_BYTES) != hipSuccess) { fprintf(stderr, "kernel_launch: hipFuncSetAttribute failed\n"); grid = -1; return; }
        if (hipOccupancyMaxActiveBlocksPerMultiprocessor(&per_cu, (const void*)mega, NTHR, LDS_BYTES) != hipSuccess || per_cu < 1) fprintf(stderr, "kernel_launch: occupancy query reports %d\n", per_cu);
        (void)hipGetLastError();
        grid = cus;
    }
    if (grid < 0) return;
    (void)hipMemsetAsync((char*)d_ws + WS_CTL, 0, CTL_ZERO_BYTES, stream);
    Args a{};
    for (int i = 0; i < 26; ++i) a.in[i] = (const float*)d_in[i];
    a.out = (float*)d_out; a.ws = (unsigned char*)d_ws;
    a.ph_lo = 0; a.ph_hi = DEPTH * NPH; a.li = 0;
    hipLaunchKernelGGL(mega, dim3(grid), dim3(NTHR), LDS_BYTES, stream, a);
}
```

```cpp
#include <hip/hip_runtime.h>
#include <stdint.h>
#include <stdio.h>
#include <math.h>

constexpr int D_MODEL = 1024, BATCH = 2, SEQ = 8192, DEPTH = 4, M_TOK = BATCH * SEQ;
constexpr int CHUNK = 64;
constexpr int A_IN = 3656, A_INP = 3840, B_DOWN = 416, B_DOWNP = 512, D_FF = 2816, UPW = 2 * D_FF;
constexpr float EPS = 1e-6f;
constexpr int NWAVES = 8, NTHR = NWAVES * 64;

#define GAS __attribute__((address_space(1)))
#define LAS __attribute__((address_space(3)))
typedef unsigned short bf16_t;
typedef unsigned v4u __attribute__((ext_vector_type(4)));
typedef unsigned v2u __attribute__((ext_vector_type(2)));
typedef float v4f __attribute__((ext_vector_type(4)));
typedef GAS unsigned gu32;
#define RLX_AGENT __ATOMIC_RELAXED, __HIP_MEMORY_SCOPE_AGENT
#define LDS_WAIT() asm volatile("s_waitcnt lgkmcnt(0)" ::: "memory")

__device__ __forceinline__ float bf2f(bf16_t v) { return __uint_as_float(((unsigned)v) << 16); }
__device__ __forceinline__ float bflo(unsigned w) { return __uint_as_float(w << 16); }
__device__ __forceinline__ float bfhi(unsigned w) { return __uint_as_float(w & 0xffff0000u); }
__device__ __forceinline__ unsigned f2bfu(float f) { unsigned u = __float_as_uint(f); return (u + 0x7fffu + ((u >> 16) & 1u)) >> 16; }
__device__ __forceinline__ bf16_t f2bf(float f) { return (bf16_t)f2bfu(f); }
typedef float pk2_f32x2_t __attribute__((ext_vector_type(2))); typedef __bf16 pk2_bf16x2_t __attribute__((ext_vector_type(2)));
__device__ __forceinline__ unsigned pk2(float lo, float hi) { const pk2_f32x2_t v = {lo, hi}; const pk2_bf16x2_t b = __builtin_convertvector(v, pk2_bf16x2_t); return __builtin_bit_cast(unsigned, b); }

__device__ __forceinline__ float wave_sum(float v) {
#pragma unroll
    for (int o = 1; o < 64; o <<= 1) v += __shfl_xor(v, o);
    return v;
}

__device__ const float c_inv[16] = {1.000000000e+00f, 5.623413324e-01f, 3.162277639e-01f, 1.778279394e-01f, 1.000000015e-01f, 5.623413250e-02f, 3.162277490e-02f, 1.778279431e-02f,
                                    9.999999776e-03f, 5.623413250e-03f, 3.162277630e-03f, 1.778279431e-03f, 1.000000047e-03f, 5.623413017e-04f, 3.162277571e-04f, 1.778279402e-04f};

__device__ __forceinline__ int t5_bucket(int rel) {
    int n = rel < 0 ? -rel : rel;
    int b;
    if (n < 8) b = n;
    else if (n < 12) b = 8; else if (n < 16) b = 9; else if (n < 23) b = 10; else if (n < 32) b = 11;
    else if (n < 46) b = 12; else if (n < 64) b = 13; else if (n < 91) b = 14; else b = 15;
    return (rel > 0 ? 16 : 0) + b;
}
__device__ __forceinline__ unsigned fkey(float f) { const unsigned u = __float_as_uint(f); return (u & 0x80000000u) ? ~u : (u | 0x80000000u); }

namespace pg8 {
#define PG8_LAS __attribute__((address_space(3)))
typedef unsigned short bf16_t;
typedef short bf16x8 __attribute__((ext_vector_type(8)));
typedef float f32x4 __attribute__((ext_vector_type(4)));
typedef unsigned u32x4 __attribute__((ext_vector_type(4)));
constexpr int BM = 256, BK = 64, HALF = 128, HTB = HALF * BK * 2  , STAGE_BYTES = 8 * HTB, NXCD = 8, WGM = 8;

__host__ __device__ __forceinline__ int lds_byte(int r, int c) { const int st = (r >> 4) * 2 + (c >> 5), rr = r & 15, cc = c & 31, ob = rr * 64 + cc * 2; return st * 1024 + (ob ^ (((ob >> 9) & 1) << 5)); }
__host__ __device__ __forceinline__ void stage_rc(int b, int& R, int& C) { const int st = b / 1024, sb = b % 1024, swz = sb ^ (((sb >> 9) & 1) << 5); R = (st >> 1) * 16 + swz / 64; C = (st & 1) * 32 + (swz % 64) / 2; }
__host__ __device__ __forceinline__ int perm32(int rho) { const int n = rho >> 4, i = rho & 15; return 8 * (i >> 2) + 4 * n + (i & 3); }

struct Unit { int pm, pn; };
struct Gemm { const bf16_t* A; const bf16_t* Bt; int M, N, K; };

struct StaticOrder {
    int nM, nN, nwg, G, c;
    __host__ __device__ void init(int M, int N, int G_, int c_) { nM = M / BM; nN = N / BM; nwg = nM * nN; G = G_; c = c_; }
    __host__ __device__ bool next(int i, Unit& u) const {
        const long L = (long)i * G + c; if (L >= nwg) return false;
        if (nM == NXCD * WGM) {
            const int xcd = (int)L & (NXCD - 1), off = (int)L >> 3;
            u.pm = WGM * xcd + (off & (WGM - 1)); u.pn = off >> 3; return true; }
        int wgid = (int)L; { const int q = nwg / NXCD, r = nwg % NXCD, xcd = wgid % NXCD, off = wgid / NXCD; wgid = (xcd < r ? xcd * (q + 1) : r * (q + 1) + (xcd - r) * q) + off; }
        const int nig = WGM * nN, gid = wgid / nig, fm = gid * WGM, gsz = (nM - fm) < WGM ? (nM - fm) : WGM;
        u.pm = fm + ((wgid % nig) % gsz); u.pn = (wgid % nig) / gsz; return true;
    }
    __device__ __forceinline__ void a_ready(const Unit&) const {}
    __device__ __forceinline__ void done(const Unit&) const {}
};

struct SliceOrder { StaticOrder so; int slice;
    __host__ __device__ bool next(int i, Unit& u) const { return i == 0 ? so.next(slice, u) : false; }
    __device__ __forceinline__ void a_ready(const Unit&) const {}
    __device__ __forceinline__ void done(const Unit&) const {} };

__device__ __forceinline__ unsigned cvt_pk_bf16(float lo, float hi) { unsigned r; asm volatile("v_cvt_pk_bf16_f32 %0, %1, %2" : "=v"(r) : "v"(lo), "v"(hi)); return r; }
typedef unsigned u32x2 __attribute__((ext_vector_type(2)));
__device__ __forceinline__ float quad_sum(float x) {
    { const unsigned u = __float_as_uint(x); const auto r = __builtin_amdgcn_permlane16_swap(u, u, false, false); x = __uint_as_float(r[0]) + __uint_as_float(r[1]); }
    { const unsigned u = __float_as_uint(x); const auto r = __builtin_amdgcn_permlane32_swap(u, u, false, false); x = __uint_as_float(r[0]) + __uint_as_float(r[1]); }
    return x;
}
__device__ __forceinline__ void row_scales(float (&rs)[2][4], const float* ssq, int row0, int fq) {
    f32x4 q[2][4];
#pragma unroll
    for (int ai = 0; ai < 2; ++ai)
#pragma unroll
        for (int m = 0; m < 4; ++m) q[ai][m] = *(const f32x4*)(ssq + (size_t)(row0 + ai * HALF + m * 16) * 16 + 4 * fq);
#pragma unroll
    for (int ai = 0; ai < 2; ++ai)
#pragma unroll
        for (int m = 0; m < 4; ++m) { float t = (q[ai][m][0] + q[ai][m][1]) + (q[ai][m][2] + q[ai][m][3]); t = quad_sum(t);
            rs[ai][m] = __builtin_amdgcn_rsqf(t * (1.0f / 1024.0f) + 1e-6f); }
}
struct EpiStore {
    static constexpr bool PERM = true, AFTER_DRAIN = false;
    bf16_t* O; int ldc; const float* ssq;
    __device__ __forceinline__ void operator()(const f32x4 (&acc)[2][2][4][2], const Unit& u, int wr, int wc, int fr, int fq) const {
        const int row0 = u.pm * BM + wr * 64 + fr; const int col0 = u.pn * BM + wc * 32 + 8 * fq;
        float rsa[2][4];
#pragma unroll
        for (int ai = 0; ai < 2; ++ai)
#pragma unroll
            for (int m = 0; m < 4; ++m) rsa[ai][m] = 1.0f;
        if (ssq) row_scales(rsa, ssq, row0, fq);
#pragma unroll
        for (int ai = 0; ai < 2; ++ai)
#pragma unroll
            for (int m = 0; m < 4; ++m) { bf16_t* rowp = O + (size_t)(row0 + ai * HALF + m * 16) * ldc + col0;
                const float rs = rsa[ai][m];
#pragma unroll
                for (int bj = 0; bj < 2; ++bj) { const f32x4 v0 = acc[ai][bj][m][0] * rs, v1 = acc[ai][bj][m][1] * rs;
                    u32x4 w; w.x = cvt_pk_bf16(v0[0], v0[1]); w.y = cvt_pk_bf16(v0[2], v0[3]); w.z = cvt_pk_bf16(v1[0], v1[1]); w.w = cvt_pk_bf16(v1[2], v1[3]);
                    *(u32x4*)(rowp + bj * HALF) = w; } }
    }
};
struct EpiResid {
    static constexpr bool PERM = false, AFTER_DRAIN = false;
    const float* base; float* out; int ldc; bf16_t* xb; float* ssq;
    __device__ __forceinline__ void operator()(const f32x4 (&acc)[2][2][4][2], const Unit& u, int wr, int wc, int fr, int fq) const {
        const int col0 = u.pn * BM + wc * 32 + 4 * fq;
#pragma unroll
        for (int ai = 0; ai < 2; ++ai) {
            f32x4 bs[4][2][2];
#pragma unroll
            for (int m = 0; m < 4; ++m) { const size_t off = (size_t)(u.pm * BM + ai * HALF + wr * 64 + m * 16 + fr) * ldc + col0;
#pragma unroll
                for (int bj = 0; bj < 2; ++bj)
#pragma unroll
                    for (int n = 0; n < 2; ++n) bs[m][bj][n] = *(const f32x4*)(base + off + bj * HALF + n * 16); }
#pragma unroll
            for (int m = 0; m < 4; ++m) { const int row = u.pm * BM + ai * HALF + wr * 64 + m * 16 + fr; const size_t off = (size_t)row * ldc + col0; float s = 0.f;
#pragma unroll
                for (int bj = 0; bj < 2; ++bj)
#pragma unroll
                    for (int n = 0; n < 2; ++n) { const f32x4 o = bs[m][bj][n] + acc[ai][bj][m][n]; *(f32x4*)(out + off + bj * HALF + n * 16) = o;
                        if (xb) { s += (o[0] * o[0] + o[1] * o[1]) + (o[2] * o[2] + o[3] * o[3]); u32x2 w; w.x = cvt_pk_bf16(o[0], o[1]); w.y = cvt_pk_bf16(o[2], o[3]); *(u32x2*)(xb + off + bj * HALF + n * 16) = w; } }
                if (xb) { s = quad_sum(s); if (fq == 0) ssq[(size_t)row * 16 + u.pn * 4 + wc] = s; }
            }
            asm volatile("" ::: "memory");
        }
    }
};


struct EpiResidB {
    static constexpr bool PERM = false, AFTER_DRAIN = false;
    bf16_t* xb; float* ssq; float* outf; int ldc; bool wxb;
    __device__ __forceinline__ void operator()(const f32x4 (&acc)[2][2][4][2], const Unit& u, int wr, int wc, int fr, int fq) const {
        const int col0 = u.pn * BM + wc * 32 + 4 * fq;
#pragma unroll
        for (int ai = 0; ai < 2; ++ai) {
            u32x2 bs[4][2][2];
#pragma unroll
            for (int m = 0; m < 4; ++m) { const size_t off = (size_t)(u.pm * BM + ai * HALF + wr * 64 + m * 16 + fr) * ldc + col0;
#pragma unroll
                for (int bj = 0; bj < 2; ++bj)
#pragma unroll
                    for (int n = 0; n < 2; ++n) bs[m][bj][n] = *(const u32x2*)(xb + off + bj * HALF + n * 16); }
#pragma unroll
            for (int m = 0; m < 4; ++m) { const int row = u.pm * BM + ai * HALF + wr * 64 + m * 16 + fr; const size_t off = (size_t)row * ldc + col0; float s = 0.f;
#pragma unroll
                for (int bj = 0; bj < 2; ++bj)
#pragma unroll
                    for (int n = 0; n < 2; ++n) { const u32x2 b = bs[m][bj][n];
                        f32x4 o; o[0] = __uint_as_float(b.x << 16) + acc[ai][bj][m][n][0]; o[1] = __uint_as_float(b.x & 0xffff0000u) + acc[ai][bj][m][n][1];
                        o[2] = __uint_as_float(b.y << 16) + acc[ai][bj][m][n][2]; o[3] = __uint_as_float(b.y & 0xffff0000u) + acc[ai][bj][m][n][3];
                        if (outf) *(f32x4*)(outf + off + bj * HALF + n * 16) = o;
                        s += (o[0] * o[0] + o[1] * o[1]) + (o[2] * o[2] + o[3] * o[3]);
                        if (wxb) { u32x2 w; w.x = cvt_pk_bf16(o[0], o[1]); w.y = cvt_pk_bf16(o[2], o[3]); *(u32x2*)(xb + off + bj * HALF + n * 16) = w; } }
                if (ssq) { s = quad_sum(s); if (fq == 0) ssq[(size_t)row * 16 + u.pn * 4 + wc] = s; }
            }
            asm volatile("" ::: "memory");
        }
    }
};

struct EpiInAC {
    static constexpr bool PERM = true, AFTER_DRAIN = false;
    bf16_t* Q; bf16_t* K; bf16_t* V; bf16_t* SI; int ldi; int nqk; const float* ssq; const float* qg; const float* kg;
    __device__ __forceinline__ void operator()(const f32x4 (&acc)[2][2][4][2], const Unit& u, int wr, int wc, int fr, int fq) const {
        const int row0 = u.pm * BM + wr * 64 + fr;
        const int sel = u.pn / nqk;
        f32x4 ga[2][2];
        float osc = 1.0f;
        if (sel < 2) { const float* g = sel ? kg : qg;
#pragma unroll
            for (int bj = 0; bj < 2; ++bj)
#pragma unroll
                for (int n = 0; n < 2; ++n) ga[bj][n] = *(const f32x4*)(g + 32 * bj + 8 * fq + 4 * n);
            if (sel == 0) osc = 0.125f * 1.4426950408889634f; }
        float rsa[2][4]; row_scales(rsa, ssq, row0, fq);
#pragma unroll
        for (int ai = 0; ai < 2; ++ai)
#pragma unroll
            for (int m = 0; m < 4; ++m) { const int row = row0 + ai * HALF + m * 16;
                const float rs = rsa[ai][m];
                f32x4 v[2][2];
#pragma unroll
                for (int bj = 0; bj < 2; ++bj)
#pragma unroll
                    for (int n = 0; n < 2; ++n) v[bj][n] = acc[ai][bj][m][n] * rs;
                if (sel < 2) {
                    float ss = 0.f;
#pragma unroll
                    for (int bj = 0; bj < 2; ++bj)
#pragma unroll
                        for (int n = 0; n < 2; ++n) ss += (v[bj][n][0] * v[bj][n][0] + v[bj][n][1] * v[bj][n][1]) + (v[bj][n][2] * v[bj][n][2] + v[bj][n][3] * v[bj][n][3]);
                    ss = quad_sum(ss);
                    const float r = osc * __builtin_amdgcn_rsqf(ss * (1.0f / 64.0f) + 1e-6f);
                    bf16_t* rowp = (sel ? K : Q) + (size_t)row * 1024 + (u.pn - sel * nqk) * 256 + wc * 64 + 8 * fq;
#pragma unroll
                    for (int bj = 0; bj < 2; ++bj) { const f32x4 v0 = v[bj][0] * r * ga[bj][0], v1 = v[bj][1] * r * ga[bj][1];
                        u32x4 w; w.x = cvt_pk_bf16(v0[0], v0[1]); w.y = cvt_pk_bf16(v0[2], v0[3]); w.z = cvt_pk_bf16(v1[0], v1[1]); w.w = cvt_pk_bf16(v1[2], v1[3]);
                        *(u32x4*)(rowp + 32 * bj) = w; }
                } else {
                    bf16_t* rowp = sel == 2 ? (V + (size_t)row * 1024 + (u.pn - 2 * nqk) * 256) : (SI + (size_t)row * ldi + (u.pn - 3 * nqk) * 256);
                    rowp += wc * 32 + 8 * fq;
#pragma unroll
                    for (int bj = 0; bj < 2; ++bj) { const f32x4 v0 = v[bj][0], v1 = v[bj][1];
                        u32x4 w; w.x = cvt_pk_bf16(v0[0], v0[1]); w.y = cvt_pk_bf16(v0[2], v0[3]); w.z = cvt_pk_bf16(v1[0], v1[1]); w.w = cvt_pk_bf16(v1[2], v1[3]);
                        *(u32x4*)(rowp + bj * HALF) = w; }
                }
            }
    }
};
template <class Epi, class Sched, bool ALIGN_EPI = false, bool SP2 = false>
__device__ __forceinline__ void gemm_phase(PG8_LAS unsigned char* lds, const Gemm g, const Sched& S, const Epi& E) {
    const int tid = threadIdx.x, wid = __builtin_amdgcn_readfirstlane(tid >> 6), lane = tid & 63, wr = wid >> 2, wc = wid & 3, fr = lane & 15, fq = lane >> 4;
    const int K = g.K, nt = K / BK;
    unsigned voffA[2], voffB[2];
#pragma unroll
    for (int i = 0; i < 2; ++i) { int R, C; stage_rc(tid * 16 + i * 8192, R, C); const int Rb = Epi::PERM ? ((R & ~31) + perm32(R & 31)) : R;
        voffA[i] = (unsigned)(R * K + C) * 2u; voffB[i] = (unsigned)(Rb * K + C) * 2u; }
    const size_t kstep = (size_t)(BK * 2);
    const size_t hstep = (size_t)HALF * K * 2;
    const size_t tstep = 2 * hstep;
    const unsigned ldsw = (unsigned)wid * 1024u;
    const int aoff = lds_byte(wr * 64 + fr, fq * 8), boff = lds_byte(wc * 32 + fr, fq * 8);
#define PG8_SA(b, h) (((b) * 2 + (h)) * HTB)
#define PG8_SB(b, h) ((4 + (b) * 2 + (h)) * HTB)
#define PG8_STAGE(bufoff, gbase, voff) do { _Pragma("unroll") for (int _i = 0; _i < 2; ++_i) \
        __builtin_amdgcn_global_load_lds((const unsigned*)((const char*)(gbase) + (voff)[_i]), (PG8_LAS unsigned*)(lds + (bufoff) + ldsw + _i * 8192), 16, 0, 0); } while (0)
#define PG8_LDA(dst, b, h) do { _Pragma("unroll") for (int m = 0; m < 4; ++m) _Pragma("unroll") for (int k = 0; k < 2; ++k) dst[m][k] = *(const PG8_LAS bf16x8*)(lds + PG8_SA(b, h) + aoff + m * 2048 + k * 1024); } while (0)
#define PG8_LDB(dst, b, h) do { _Pragma("unroll") for (int n = 0; n < 2; ++n) _Pragma("unroll") for (int k = 0; k < 2; ++k) dst[n][k] = *(const PG8_LAS bf16x8*)(lds + PG8_SB(b, h) + boff + n * 2048 + k * 1024); } while (0)
#define PG8_MMA(ai, bj, At, Bt) do { __builtin_amdgcn_s_setprio(1); _Pragma("unroll") for (int m = 0; m < 4; ++m) _Pragma("unroll") for (int n = 0; n < 2; ++n) _Pragma("unroll") for (int k = 0; k < 2; ++k) \
        acc[ai][bj][m][n] = __builtin_amdgcn_mfma_f32_16x16x32_bf16(Bt[n][k], At[m][k], acc[ai][bj][m][n], 0, 0, 0); __builtin_amdgcn_s_setprio(0); } while (0)
#define PG8_WAIT_V(n) asm volatile("s_waitcnt vmcnt(" #n ")" ::: "memory")
#define PG8_WAIT_L(n) asm volatile("s_waitcnt lgkmcnt(" #n ")" ::: "memory")
#define PG8_BAR __builtin_amdgcn_s_barrier()
#define PG8_SCHED __builtin_amdgcn_sched_barrier(0)
    Unit cur, nxt; int ui = 0;
    if (!S.next(0, cur)) return;
    f32x4 acc[2][2][4][2];
#pragma unroll
    for (int a = 0; a < 2; ++a)
#pragma unroll
        for (int b = 0; b < 2; ++b)
#pragma unroll
            for (int m = 0; m < 4; ++m)
#pragma unroll
                for (int n = 0; n < 2; ++n) acc[a][b][m][n] = (f32x4){0.f, 0.f, 0.f, 0.f};
    bf16x8 At[4][2], B0[2][2], B1[2][2];
    const char* cA = (const char*)g.A + (size_t)cur.pm * tstep; const char* cB = (const char*)g.Bt + (size_t)cur.pn * tstep;
    S.a_ready(cur);
    if constexpr (SP2) {
        PG8_STAGE(PG8_SB(0, 0), cB, voffB); PG8_STAGE(PG8_SB(0, 1), cB + hstep, voffB); PG8_STAGE(PG8_SA(0, 0), cA, voffA); PG8_STAGE(PG8_SA(0, 1), cA + hstep, voffA);
        if (wr == 1) PG8_BAR;
        PG8_WAIT_V(2); PG8_BAR;
        PG8_STAGE(PG8_SB(1, 0), cB + kstep, voffB); PG8_STAGE(PG8_SA(1, 0), cA + kstep, voffA); PG8_STAGE(PG8_SB(1, 1), cB + hstep + kstep, voffB);
        PG8_WAIT_V(6); PG8_BAR;
    } else {
        PG8_STAGE(PG8_SB(0, 0), cB, voffB); PG8_STAGE(PG8_SA(0, 0), cA, voffA); PG8_STAGE(PG8_SB(0, 1), cB + hstep, voffB); PG8_STAGE(PG8_SA(0, 1), cA + hstep, voffA);
        if (wr == 1) PG8_BAR;
        PG8_WAIT_V(4); PG8_BAR;
        PG8_STAGE(PG8_SB(1, 0), cB + kstep, voffB); PG8_STAGE(PG8_SA(1, 0), cA + kstep, voffA); PG8_STAGE(PG8_SB(1, 1), cB + hstep + kstep, voffB);
        PG8_WAIT_V(6); PG8_BAR;
    }
    for (;;) {
        const bool has_next = S.next(ui + 1, nxt);
        const char* nA = has_next ? (const char*)g.A + (size_t)nxt.pm * tstep : cA; const char* nB = has_next ? (const char*)g.Bt + (size_t)nxt.pn * tstep : cB;
        for (int t = 0; t < nt; t += 2) {
            const bool last = (t == nt - 2);
            const char* a1 = cA + (size_t)(t + 1) * kstep;
            const char* a2 = last ? nA : cA + (size_t)(t + 2) * kstep; const char* b2 = last ? nB : cB + (size_t)(t + 2) * kstep;
            const char* a3 = a2 + kstep; const char* b3 = b2 + kstep;
            if (last && has_next) S.a_ready(nxt);
            if constexpr (SP2) {
            PG8_LDB(B0, 0, 0); PG8_LDB(B1, 0, 1); PG8_SCHED; PG8_LDA(At, 0, 0); PG8_STAGE(PG8_SA(1, 1), a1 + hstep, voffA);
            PG8_WAIT_V(8); PG8_WAIT_L(0); PG8_BAR; PG8_MMA(0, 0, At, B0); PG8_MMA(0, 1, At, B1); PG8_BAR; PG8_SCHED;
            PG8_LDA(At, 0, 1); PG8_STAGE(PG8_SB(0, 0), b2, voffB); PG8_STAGE(PG8_SB(0, 1), b2 + hstep, voffB); PG8_STAGE(PG8_SA(0, 0), a2, voffA);
            PG8_WAIT_V(8); PG8_WAIT_L(0); PG8_BAR; PG8_MMA(1, 0, At, B0); PG8_MMA(1, 1, At, B1); PG8_BAR; PG8_SCHED;
            PG8_LDB(B0, 1, 0); PG8_LDB(B1, 1, 1); PG8_SCHED; PG8_LDA(At, 1, 0); PG8_STAGE(PG8_SA(0, 1), a2 + hstep, voffA);
            PG8_WAIT_V(8); PG8_WAIT_L(0); PG8_BAR; PG8_MMA(0, 0, At, B0); PG8_MMA(0, 1, At, B1); PG8_BAR; PG8_SCHED;
            PG8_LDA(At, 1, 1); PG8_STAGE(PG8_SB(1, 0), b3, voffB); PG8_STAGE(PG8_SB(1, 1), b3 + hstep, voffB); PG8_STAGE(PG8_SA(1, 0), a3, voffA);
            PG8_WAIT_V(8); PG8_WAIT_L(0); PG8_BAR; PG8_MMA(1, 0, At, B0); PG8_MMA(1, 1, At, B1); PG8_BAR; PG8_SCHED;
            } else {
            PG8_LDB(B0, 0, 0); PG8_SCHED; PG8_LDA(At, 0, 0); PG8_STAGE(PG8_SA(1, 1), a1 + hstep, voffA);
            PG8_WAIT_L(8); PG8_BAR; PG8_WAIT_L(0); PG8_MMA(0, 0, At, B0); PG8_BAR; PG8_SCHED;
            PG8_LDB(B1, 0, 1); PG8_STAGE(PG8_SB(0, 0), b2, voffB);
            PG8_BAR; PG8_WAIT_L(0); PG8_MMA(0, 1, At, B1); PG8_BAR;
            PG8_LDA(At, 0, 1); PG8_STAGE(PG8_SA(0, 0), a2, voffA);
            PG8_BAR; PG8_WAIT_L(0); PG8_MMA(1, 0, At, B0); PG8_BAR; PG8_SCHED;
            PG8_STAGE(PG8_SB(0, 1), b2 + hstep, voffB);
            PG8_WAIT_V(6); PG8_BAR; PG8_MMA(1, 1, At, B1); PG8_BAR;
            PG8_LDB(B0, 1, 0); PG8_SCHED; PG8_LDA(At, 1, 0); PG8_STAGE(PG8_SA(0, 1), a2 + hstep, voffA);
            PG8_WAIT_L(8); PG8_BAR; PG8_WAIT_L(0); PG8_MMA(0, 0, At, B0); PG8_BAR; PG8_SCHED;
            PG8_LDB(B1, 1, 1); PG8_STAGE(PG8_SB(1, 0), b3, voffB);
            PG8_BAR; PG8_WAIT_L(0); PG8_MMA(0, 1, At, B1); PG8_BAR;
            PG8_LDA(At, 1, 1); PG8_STAGE(PG8_SA(1, 0), a3, voffA);
            PG8_BAR; PG8_WAIT_L(0); PG8_MMA(1, 0, At, B0); PG8_BAR; PG8_SCHED;
            PG8_STAGE(PG8_SB(1, 1), b3 + hstep, voffB);
            PG8_WAIT_V(6); PG8_BAR; PG8_MMA(1, 1, At, B1); PG8_BAR;
            }
        }
        if constexpr (ALIGN_EPI) { if (wr == 0) PG8_BAR; }
        if constexpr (!Epi::AFTER_DRAIN) { E(acc, cur, wr, wc, fr, fq); S.done(cur); }
        if (!has_next) break;
#pragma unroll
        for (int a = 0; a < 2; ++a)
#pragma unroll
            for (int b = 0; b < 2; ++b)
#pragma unroll
                for (int m = 0; m < 4; ++m)
#pragma unroll
                    for (int n = 0; n < 2; ++n) acc[a][b][m][n] = (f32x4){0.f, 0.f, 0.f, 0.f};
        cur = nxt; cA = nA; cB = nB; ++ui;
        if constexpr (ALIGN_EPI) { if (wr == 1) PG8_BAR; }
    }
    PG8_WAIT_V(0);
    if constexpr (!ALIGN_EPI) { if (wr == 0) PG8_BAR; }
    PG8_BAR;
    if constexpr (Epi::AFTER_DRAIN) { E.fused(acc, cur, wr, wc, fr, fq, lds, wid, lane); S.done(cur); }
#undef PG8_SA
#undef PG8_SB
#undef PG8_STAGE
#undef PG8_LDA
#undef PG8_LDB
#undef PG8_MMA
#undef PG8_WAIT_V
#undef PG8_WAIT_L
#undef PG8_BAR
#undef PG8_SCHED
}
}
#define XB_TMO      128
#define XB_XCNT(j)  (256  + 64 * (j))
#define XB_XSUB(j)  (1280 + 64 * (j))
#define XB_XGEN(j)  (2304 + 64 * (j))
#define XB_TOP      3328
#define XB_TOPGEN   3392
#define XCD_BAR_WORDS 3456
#define XB_SPIN_CAP (1u << 18)

__device__ __forceinline__ unsigned xb_ld(unsigned* p)              { return __hip_atomic_load(p, __ATOMIC_RELAXED, __HIP_MEMORY_SCOPE_AGENT); }
__device__ __forceinline__ unsigned xb_add(unsigned* p, unsigned v) { return __hip_atomic_fetch_add(p, v, __ATOMIC_RELAXED, __HIP_MEMORY_SCOPE_AGENT); }
__device__ __forceinline__ unsigned xb_xcc_id() { return (unsigned)__builtin_amdgcn_s_getreg((3 << 11) | 20) & 0xFu; }
#define XB_SPIN(cond, bar) do { unsigned _sp = 0; while (cond) { __builtin_amdgcn_s_sleep(1); \
    if ((++_sp & 255u) == 0u) { if (xb_ld(&(bar)[XB_TMO])) break; if (_sp > XB_SPIN_CAP) { atomicAdd(&(bar)[XB_TMO], 1u); break; } } } } while (0)

struct XcdBarrier {
    unsigned* bar; unsigned x;
    volatile LAS unsigned* st;
};

__device__ __forceinline__ XcdBarrier xcd_barrier_post(unsigned* bar, volatile LAS unsigned* st) {
    XcdBarrier b; b.bar = bar; b.x = xb_xcc_id(); b.st = st;
    if (threadIdx.x == 0) (void)xb_add(&bar[XB_XCNT(b.x)], 1u);
    return b;
}
__device__ __forceinline__ void xcd_barrier_complete(unsigned* bar, unsigned x, unsigned& nloc, unsigned& nx) {
    const unsigned G = gridDim.x * gridDim.y * gridDim.z;
    unsigned sum, cnt, mine, sp = 0u;
    for (;;) {
        sum = 0u; cnt = 0u; mine = 0u;
#pragma unroll
        for (unsigned j = 0; j < 16; ++j) { const unsigned c = xb_ld(&bar[XB_XCNT(j)]); sum += c; cnt += (c > 0u) ? 1u : 0u; mine = (j == x) ? c : mine; }
        if (sum == G) break;
        __builtin_amdgcn_s_sleep(1);
        if ((++sp & 255u) == 0u) { if (xb_ld(&bar[XB_TMO])) break; if (sp > XB_SPIN_CAP) { atomicAdd(&bar[XB_TMO], 1u); break; } }
    }
    nloc = mine > 0u ? mine : 1u; nx = cnt > 0u ? cnt : 1u;
}

__device__ __forceinline__ void xcd_barrier(const XcdBarrier& b) {
    asm volatile("s_waitcnt vmcnt(0)" ::: "memory");
    __syncthreads();
    if (threadIdx.x == 0) {
        unsigned* bar = b.bar;
        __builtin_amdgcn_s_waitcnt(0);
        unsigned nloc = b.st[0], nx = b.st[1];
        if (nloc == 0u) { xcd_barrier_complete(bar, b.x, nloc, nx); b.st[0] = nloc; b.st[1] = nx; }
        const unsigned old = xb_add(&bar[XB_XSUB(b.x)], 1u);
        const unsigned gen = old / nloc;
        if (old + 1u == (gen + 1u) * nloc) {
            __builtin_amdgcn_fence(__ATOMIC_RELEASE, "agent");
            asm volatile("s_waitcnt vmcnt(0)" ::: "memory");
            const unsigned og = xb_add(&bar[XB_TOP], 1u);
            const unsigned tg = og / nx;
            if (og + 1u == (tg + 1u) * nx) xb_add(&bar[XB_TOPGEN], 1u);
            else XB_SPIN(xb_ld(&bar[XB_TOPGEN]) == tg, bar);
            __builtin_amdgcn_fence(__ATOMIC_ACQUIRE, "agent");
            xb_add(&bar[XB_XGEN(b.x)], 1u);
            asm volatile("s_waitcnt vmcnt(0)" ::: "memory");
        } else {
            XB_SPIN(xb_ld(&bar[XB_XGEN(b.x)]) == gen, bar);
            __builtin_amdgcn_fence(__ATOMIC_ACQUIRE, "agent");
            asm volatile("s_waitcnt vmcnt(0)" ::: "memory");
        }
    }
    __syncthreads();
}

__device__ __forceinline__ void tr_item(const float* W, int K, int N, bf16_t* WT, LAS float* scr, int item, int nblk, int lane, const float* gk, int headcols = 0) {
    const int kb = item / nblk, nb = item % nblk, k0 = 64 * kb, n0 = 32 * nb;
    const int n_in = n0 + (lane & 31);
    int r0 = n0; if (n0 < headcols) r0 = (n0 & ~255) + 128 * ((n0 & 63) >> 5) + 32 * ((n0 & 255) >> 6);
    if (headcols < 0) { const int isv = n0 >= D_FF ? 1 : 0, ch0 = n0 - isv * D_FF; r0 = 256 * (ch0 >> 7) + 128 * isv + (ch0 & 127); }
#pragma unroll
    for (int i = 0; i < 32; ++i) { const int kk = 2 * i + (lane >> 5); scr[kk * 33 + (lane & 31)] = (n_in < N) ? W[(size_t)(k0 + kk) * N + n_in] : 0.f; }
    LDS_WAIT(); asm volatile("" ::: "memory");
    const int c = lane & 7;
    v4f ga = {1.f, 1.f, 1.f, 1.f}, gb = ga;
    if (gk) { ga = *(const v4f*)(gk + k0 + 8 * c); gb = *(const v4f*)(gk + k0 + 8 * c + 4); }
#pragma unroll
    for (int j = 0; j < 4; ++j) { const int n = (lane >> 3) + 8 * j; const LAS float* s = scr + (8 * c) * 33 + n;
        v4u o; o.x = pk2(s[0 * 33] * ga.x, s[1 * 33] * ga.y); o.y = pk2(s[2 * 33] * ga.z, s[3 * 33] * ga.w); o.z = pk2(s[4 * 33] * gb.x, s[5 * 33] * gb.y); o.w = pk2(s[6 * 33] * gb.z, s[7 * 33] * gb.w);
        *(v4u*)(WT + (size_t)(r0 + n) * K + k0 + 8 * c) = o; }
    LDS_WAIT(); asm volatile("" ::: "memory");
}
__device__ __forceinline__ void xb_row(const float* xrow, bf16_t* orow, float* ssq, int lane) {
    const v4f* xr = (const v4f*)xrow + lane;
    v4f v[4]; float s = 0.f;
#pragma unroll
    for (int j = 0; j < 4; ++j) { v[j] = xr[64 * j]; s += (v[j].x * v[j].x + v[j].y * v[j].y) + (v[j].z * v[j].z + v[j].w * v[j].w); }
    s = wave_sum(s);
    v2u* o8 = (v2u*)orow + lane;
#pragma unroll
    for (int j = 0; j < 4; ++j) { v2u o; o.x = pk2(v[j].x, v[j].y); o.y = pk2(v[j].z, v[j].w); o8[64 * j] = o; }
    if (lane < 16) ssq[lane] = lane == 0 ? s : 0.f;
}
__device__ __forceinline__ void xb_rows4(const float* __restrict__ x, bf16_t* __restrict__ xb, float* __restrict__ ssq, int m0, int mstride, int lane) {
    v4f v[4][4];
#pragma unroll
    for (int r = 0; r < 4; ++r) { int row = m0 + r * mstride; row = row < M_TOK ? row : M_TOK - 1; const v4f* xr = (const v4f*)(x + (size_t)row * D_MODEL) + lane;
#pragma unroll
        for (int j = 0; j < 4; ++j) v[r][j] = xr[64 * j]; }
#pragma unroll
    for (int r = 0; r < 4; ++r) { const int row = m0 + r * mstride;
        if (row < M_TOK) { float s = 0.f;
#pragma unroll
            for (int j = 0; j < 4; ++j) s += (v[r][j].x * v[r][j].x + v[r][j].y * v[r][j].y) + (v[r][j].z * v[r][j].z + v[r][j].w * v[r][j].w);
            s = wave_sum(s);
            v2u* o8 = (v2u*)(xb + (size_t)row * D_MODEL) + lane;
#pragma unroll
            for (int j = 0; j < 4; ++j) { v2u o; o.x = pk2(v[r][j].x, v[r][j].y); o.y = pk2(v[r][j].z, v[r][j].w); o8[64 * j] = o; }
            if (lane < 16) ssq[(size_t)row * 16 + lane] = lane == 0 ? s : 0.f; } }
}
__device__ __forceinline__ void rope_fill(float* ROPE, int gw, int NGW, int lane) {
    for (int it = gw * 64 + lane; it < SEQ * 16; it += NGW * 64) { const int pos = it >> 4, i = it & 15; float sn, cs; sincosf((float)pos * c_inv[i], &sn, &cs);
        ROPE[pos * 32 + i] = cs; ROPE[pos * 32 + 16 + i] = sn; }
}
__device__ __forceinline__ void unpack8(const v4u w, float (&x)[8]) { x[0] = bflo(w.x); x[1] = bfhi(w.x); x[2] = bflo(w.y); x[3] = bfhi(w.y); x[4] = bflo(w.z); x[5] = bfhi(w.z); x[6] = bflo(w.w); x[7] = bfhi(w.w); }
__device__ __forceinline__ v4u pack8(const float (&x)[8]) { v4u w; w.x = pk2(x[0], x[1]); w.y = pk2(x[2], x[3]); w.z = pk2(x[4], x[5]); w.w = pk2(x[6], x[7]); return w; }

struct AcIn { v4u q0, q1, k0, k1, v0, v1, qi, ki; float cs[8], sn[8]; float wi; };
template <bool IDX>
__device__ __forceinline__ void ac_load(AcIn& in, const bf16_t* S, int row, const float* ROPE, int lane) {
    const v4u* sq = (const v4u*)(S + 16 * lane); const v4u* sk = (const v4u*)(S + 1024 + 16 * lane); const v4u* sv = (const v4u*)(S + 2048 + 16 * lane);
    in.q0 = sq[0]; in.q1 = sq[1]; in.k0 = sk[0]; in.k1 = sk[1]; in.v0 = sv[0]; in.v1 = sv[1];
    if (IDX) {
        const int pos = row % SEQ; const float* rp = ROPE + pos * 32; const int l8 = lane & 7, ib = (l8 & 1) * 8;
        in.qi = *(const v4u*)(S + 3072 + 8 * lane); in.ki = *(const v4u*)(S + 3584 + 8 * l8); in.wi = bf2f(S[3648 + l8]);
#pragma unroll
        for (int e = 0; e < 8; ++e) { in.cs[e] = rp[ib + e]; in.sn[e] = rp[16 + ib + e]; }
    }
}
template <bool IDX>
__device__ __forceinline__ void ac_compute(const AcIn& in, int row, const float* qg, const float* kg, const float* kig,
                                           bf16_t* Q, bf16_t* K, bf16_t* V, bf16_t* QI, bf16_t* KI, float* WI, int lane) {
#pragma unroll
    for (int t = 0; t < 2; ++t) {
        float x[16]; { float a[8], b[8]; unpack8(t ? in.k0 : in.q0, a); unpack8(t ? in.k1 : in.q1, b);
#pragma unroll
            for (int e = 0; e < 8; ++e) { x[e] = a[e]; x[8 + e] = b[e]; } }
        float ss = 0.f;
#pragma unroll
        for (int e = 0; e < 16; ++e) ss += x[e] * x[e];
        ss += __shfl_xor(ss, 1); ss += __shfl_xor(ss, 2);
        const float r = (1.0f / sqrtf(ss * (1.0f / 64.0f) + EPS)) * (t ? 1.0f : 0.125f * 1.4426950408889634f);
        const float* g = (t ? kg : qg) + (lane & 3) * 16;
        float a[8], b[8];
#pragma unroll
        for (int e = 0; e < 8; ++e) { a[e] = x[e] * r * g[e]; b[e] = x[8 + e] * r * g[8 + e]; }
        v4u* op = (v4u*)((t ? K : Q) + (size_t)row * 1024 + 16 * lane);
        op[0] = pack8(a); op[1] = pack8(b);
    }
    { v4u* op = (v4u*)(V + (size_t)row * 1024 + 16 * lane); op[0] = in.v0; op[1] = in.v1; }
    if (IDX) {
        const int pos = row % SEQ; const int l8 = lane & 7;
        { float x[8], xp[8], o[8]; unpack8(in.qi, x);
#pragma unroll
            for (int e = 0; e < 8; ++e) xp[e] = __shfl_xor(x[e], 2);
#pragma unroll
            for (int e = 0; e < 8; ++e) o[e] = (l8 < 4) ? x[e] : ((l8 < 6) ? (x[e] * in.cs[e] - xp[e] * in.sn[e]) : (xp[e] * in.sn[e] + x[e] * in.cs[e]));
            *(v4u*)(QI + (size_t)row * 512 + 8 * lane) = pack8(o); }
        { float x[8], y[8], yp[8], o[8]; unpack8(in.ki, x);
            float ss = 0.f;
#pragma unroll
            for (int e = 0; e < 8; ++e) ss += x[e] * x[e];
            ss += __shfl_xor(ss, 1); ss += __shfl_xor(ss, 2); ss += __shfl_xor(ss, 4);
            const float r = 1.0f / sqrtf(ss * (1.0f / 64.0f) + EPS);
#pragma unroll
            for (int e = 0; e < 8; ++e) y[e] = x[e] * r * kig[l8 * 8 + e];
#pragma unroll
            for (int e = 0; e < 8; ++e) yp[e] = __shfl_xor(y[e], 2);
#pragma unroll
            for (int e = 0; e < 8; ++e) o[e] = (l8 < 4) ? y[e] : ((l8 < 6) ? (y[e] * in.cs[e] - yp[e] * in.sn[e]) : (yp[e] * in.sn[e] + y[e] * in.cs[e]));
            if (lane < 8) *(v4u*)(KI + (size_t)(row - pos) * 64 + (size_t)(((pos >> 5) * 4 + (lane >> 1)) * 64 + (lane & 1) * 32 + (pos & 31)) * 8) = pack8(o); }
        if (lane < 8) WI[(size_t)row * 8 + lane] = in.wi;
    }
}
template <bool IDX>
__device__ __forceinline__ void post_ac_rows(const bf16_t* SB, int ld, int gw, int NGW, const float* qg, const float* kg, const float* kig, const float* ROPE,
                                             bf16_t* Q, bf16_t* K, bf16_t* V, bf16_t* QI, bf16_t* KI, float* WI, int lane) {
    AcIn cur = AcIn{}, nxt = AcIn{};
    if (gw < M_TOK) ac_load<IDX>(cur, SB + (size_t)gw * ld, gw, ROPE, lane);
    for (int m = gw; m < M_TOK; m += NGW) {
        const int mn = m + NGW;
        if (mn < M_TOK) ac_load<IDX>(nxt, SB + (size_t)mn * ld, mn, ROPE, lane);
        ac_compute<IDX>(cur, m, qg, kg, kig, Q, K, V, QI, KI, WI, lane);
        cur = nxt;
    }
}
struct IdxIn { v4u qi, ki; float cs[8], sn[8]; float wi; };
__device__ __forceinline__ void idx_load(IdxIn& in, const bf16_t* S, int row, const float* ROPE, int lane) {
    const int pos = row % SEQ; const float* rp = ROPE + pos * 32; const int l8 = lane & 7, ib = (l8 & 1) * 8;
    in.qi = *(const v4u*)(S + 8 * lane); in.ki = *(const v4u*)(S + 512 + 8 * l8); in.wi = bf2f(S[576 + l8]);
#pragma unroll
    for (int e = 0; e < 8; ++e) { in.cs[e] = rp[ib + e]; in.sn[e] = rp[16 + ib + e]; }
}
__device__ __forceinline__ void idx_compute(const IdxIn& in, int row, const float* kig, bf16_t* QI, bf16_t* KI, float* WI, int lane) {
    const int pos = row % SEQ; const int l8 = lane & 7;
    { float x[8], xp[8], o[8]; unpack8(in.qi, x);
#pragma unroll
        for (int e = 0; e < 8; ++e) xp[e] = __shfl_xor(x[e], 2);
#pragma unroll
        for (int e = 0; e < 8; ++e) o[e] = (l8 < 4) ? x[e] : ((l8 < 6) ? (x[e] * in.cs[e] - xp[e] * in.sn[e]) : (xp[e] * in.sn[e] + x[e] * in.cs[e]));
        *(v4u*)(QI + (size_t)row * 512 + 8 * lane) = pack8(o); }
    { float x[8], y[8], yp[8], o[8]; unpack8(in.ki, x);
        float ss = 0.f;
#pragma unroll
        for (int e = 0; e < 8; ++e) ss += x[e] * x[e];
        ss += __shfl_xor(ss, 1); ss += __shfl_xor(ss, 2); ss += __shfl_xor(ss, 4);
        const float r = 1.0f / sqrtf(ss * (1.0f / 64.0f) + EPS);
#pragma unroll
        for (int e = 0; e < 8; ++e) y[e] = x[e] * r * kig[l8 * 8 + e];
#pragma unroll
        for (int e = 0; e < 8; ++e) yp[e] = __shfl_xor(y[e], 2);
#pragma unroll
        for (int e = 0; e < 8; ++e) o[e] = (l8 < 4) ? y[e] : ((l8 < 6) ? (y[e] * in.cs[e] - yp[e] * in.sn[e]) : (yp[e] * in.sn[e] + y[e] * in.cs[e]));
        if (lane < 8) *(v4u*)(KI + (size_t)(row - pos) * 64 + (size_t)(((pos >> 5) * 4 + (lane >> 1)) * 64 + (lane & 1) * 32 + (pos & 31)) * 8) = pack8(o); }
    if (lane < 8) WI[(size_t)row * 8 + lane] = in.wi;
}
__device__ __forceinline__ void post_idx_rows(const bf16_t* SB, int ld, int gw, int NGW, const float* kig, const float* ROPE, bf16_t* QI, bf16_t* KI, float* WI, int lane) {
    for (int m = gw; m < M_TOK; m += 4 * NGW) {
        IdxIn in[4];
#pragma unroll
        for (int r = 0; r < 4; ++r) { int row = m + r * NGW; row = row < M_TOK ? row : M_TOK - 1; idx_load(in[r], SB + (size_t)row * ld, row, ROPE, lane); }
#pragma unroll
        for (int r = 0; r < 4; ++r) { const int row = m + r * NGW; if (row < M_TOK) idx_compute(in[r], row, kig, QI, KI, WI, lane); }
    }
}
__device__ __forceinline__ void post_b1_row(const bf16_t* __restrict__ S, int row, const float* __restrict__ qag, const float* __restrict__ kvag, bf16_t* __restrict__ CQN, bf16_t* __restrict__ CKVN, float* __restrict__ KR, int lane) {
    { const v2u w = *(const v2u*)(S + 4 * lane); const float x0 = bflo(w.x), x1 = bfhi(w.x), x2 = bflo(w.y), x3 = bfhi(w.y);
        const float r = 1.0f / sqrtf(wave_sum((x0 * x0 + x1 * x1) + (x2 * x2 + x3 * x3)) * (1.0f / 256.0f) + EPS);
        const v4f g = *(const v4f*)(qag + 4 * lane); v2u o; o.x = pk2(x0 * r * g.x, x1 * r * g.y); o.y = pk2(x2 * r * g.z, x3 * r * g.w);
        *(v2u*)(CQN + (size_t)row * 256 + 4 * lane) = o; }
    { const unsigned w = *(const unsigned*)(S + 256 + 2 * lane); const float x0 = bflo(w), x1 = bfhi(w);
        const float r = 1.0f / sqrtf(wave_sum(x0 * x0 + x1 * x1) * (1.0f / 128.0f) + EPS);
        *(unsigned*)(CKVN + (size_t)row * 128 + 2 * lane) = pk2(x0 * r * kvag[2 * lane], x1 * r * kvag[2 * lane + 1]); }
    if (lane < 32) KR[(size_t)row * 32 + lane] = bf2f(S[384 + lane]);
}
template <int R>
__device__ __forceinline__ void post_b1_rows(const bf16_t* __restrict__ SB, int m0, int mstride, const float* __restrict__ qag, const float* __restrict__ kvag, bf16_t* __restrict__ CQN, bf16_t* __restrict__ CKVN, float* __restrict__ KR, int lane) {
    v2u w[R]; unsigned w2[R]; bf16_t kr[R];
#pragma unroll
    for (int r = 0; r < R; ++r) { const int row = m0 + r * mstride; w[r] = (v2u){0u, 0u}; w2[r] = 0u; kr[r] = 0;
        if (row < M_TOK) { const bf16_t* S = SB + (size_t)row * B_DOWNP; w[r] = *(const v2u*)(S + 4 * lane); w2[r] = *(const unsigned*)(S + 256 + 2 * lane); kr[r] = S[384 + (lane & 31)]; } }
    const v4f g = *(const v4f*)(qag + 4 * lane); const float kg0 = kvag[2 * lane], kg1 = kvag[2 * lane + 1];
#pragma unroll
    for (int r = 0; r < R; ++r) { const int row = m0 + r * mstride;
        if (row < M_TOK) {
            { const float x0 = bflo(w[r].x), x1 = bfhi(w[r].x), x2 = bflo(w[r].y), x3 = bfhi(w[r].y);
              const float rs = 1.0f / sqrtf(wave_sum((x0 * x0 + x1 * x1) + (x2 * x2 + x3 * x3)) * (1.0f / 256.0f) + EPS);
              v2u o; o.x = pk2(x0 * rs * g.x, x1 * rs * g.y); o.y = pk2(x2 * rs * g.z, x3 * rs * g.w);
              *(v2u*)(CQN + (size_t)row * 256 + 4 * lane) = o; }
            { const float x0 = bflo(w2[r]), x1 = bfhi(w2[r]);
              const float rs = 1.0f / sqrtf(wave_sum(x0 * x0 + x1 * x1) * (1.0f / 128.0f) + EPS);
              *(unsigned*)(CKVN + (size_t)row * 128 + 2 * lane) = pk2(x0 * rs * kg0, x1 * rs * kg1); }
            if (lane < 32) KR[(size_t)row * 32 + lane] = bf2f(kr[r]);
        } }
}
__device__ __forceinline__ void post_b2_row(const bf16_t* __restrict__ SQ, const bf16_t* __restrict__ SKV, const float* __restrict__ kr, int row, const float* __restrict__ qg, const float* __restrict__ kg, const float* __restrict__ ROPE,
                                            bf16_t* __restrict__ QB, bf16_t* __restrict__ KB, bf16_t* __restrict__ VB, int lane) {
    const int pos = row % SEQ; const float* rp = ROPE + pos * 32;
    const int hn = lane >> 2, part = lane & 3;
    const int l5 = lane & 31, hr = l5 >> 1, half = l5 & 1;
    float cs[8], sn[8];
#pragma unroll
    for (int e = 0; e < 8; ++e) { cs[e] = rp[8 * half + e]; sn[e] = rp[16 + 8 * half + e]; }
    for (int t = 1; t < 2; ++t) {
        float x[16], x1[8], x2[8];
        { const bf16_t* np = t ? (SKV + hn * 128 + part * 16) : (SQ + hn * 96 + part * 16); float a[8], b[8]; unpack8(((const v4u*)np)[0], a); unpack8(((const v4u*)np)[1], b);
#pragma unroll
            for (int e = 0; e < 8; ++e) { x[e] = a[e]; x[8 + e] = b[e]; } }
        if (t) {
#pragma unroll
            for (int e = 0; e < 8; ++e) { x1[e] = kr[8 * half + e]; x2[e] = kr[16 + 8 * half + e]; }
        } else { unpack8(*(const v4u*)(SQ + hr * 96 + 64 + 8 * half), x1); unpack8(*(const v4u*)(SQ + hr * 96 + 80 + 8 * half), x2); }
        float sn_ = 0.f, sr_ = 0.f;
#pragma unroll
        for (int e = 0; e < 16; ++e) sn_ += x[e] * x[e];
#pragma unroll
        for (int e = 0; e < 8; ++e) sr_ += x1[e] * x1[e] + x2[e] * x2[e];
        sn_ += __shfl_xor(sn_, 1); sn_ += __shfl_xor(sn_, 2);
        sr_ += __shfl_xor(sr_, 1);
        const float tot_n = sn_ + __shfl(sr_, 2 * hn);
        const float tot_r = sr_ + __shfl(sn_, 4 * hr);
        const float qs = t ? 1.0f : 0.10206207261596577f * 1.4426950408889634f;
        const float rn = qs / sqrtf(tot_n * (1.0f / 96.0f) + EPS), rr = qs / sqrtf(tot_r * (1.0f / 96.0f) + EPS);
        const float* g = t ? kg : qg;
        bf16_t* out = (t ? KB : QB) + (size_t)row * 1536;
        { float a[8], b[8];
#pragma unroll
            for (int e = 0; e < 8; ++e) { a[e] = x[e] * rn * g[part * 16 + e]; b[e] = x[8 + e] * rn * g[part * 16 + 8 + e]; }
            v4u* op = (v4u*)(out + hn * 96 + part * 16); op[0] = pack8(a); op[1] = pack8(b); }
        { float o1[8], o2[8];
#pragma unroll
            for (int e = 0; e < 8; ++e) { const float y1 = x1[e] * rr * g[64 + 8 * half + e], y2 = x2[e] * rr * g[80 + 8 * half + e]; o1[e] = y1 * cs[e] - y2 * sn[e]; o2[e] = y1 * sn[e] + y2 * cs[e]; }
            if (lane < 32) { *(v4u*)(out + hr * 96 + 64 + 8 * half) = pack8(o1); *(v4u*)(out + hr * 96 + 80 + 8 * half) = pack8(o2); } }
    }
}
template <int R>
__device__ __forceinline__ void post_b2k_rows(const bf16_t* __restrict__ SKVB, const float* __restrict__ KRB, int m0, int mstride, const float* __restrict__ kg, const float* __restrict__ ROPE, bf16_t* __restrict__ KB, int lane) {
    const int hn = lane >> 2, part = lane & 3;
    const int l5 = lane & 31, hr = l5 >> 1, half = l5 & 1;
    v4u n0[R], n1[R]; v4f ka[R], kb[R], kc[R], kd[R], ca[R], cb2[R], sa[R], sb[R];
#pragma unroll
    for (int r = 0; r < R; ++r) { int row = m0 + r * mstride; row = row < M_TOK ? row : M_TOK - 1;
        const bf16_t* np = SKVB + (size_t)row * 2048 + hn * 128 + part * 16; n0[r] = ((const v4u*)np)[0]; n1[r] = ((const v4u*)np)[1];
        const float* kr = KRB + (size_t)row * 32; ka[r] = *(const v4f*)(kr + 8 * half); kb[r] = *(const v4f*)(kr + 8 * half + 4); kc[r] = *(const v4f*)(kr + 16 + 8 * half); kd[r] = *(const v4f*)(kr + 16 + 8 * half + 4);
        const float* rp = ROPE + (row % SEQ) * 32; ca[r] = *(const v4f*)(rp + 8 * half); cb2[r] = *(const v4f*)(rp + 8 * half + 4); sa[r] = *(const v4f*)(rp + 16 + 8 * half); sb[r] = *(const v4f*)(rp + 16 + 8 * half + 4); }
    float gn[16], g1[8], g2[8];
#pragma unroll
    for (int e = 0; e < 16; ++e) gn[e] = kg[part * 16 + e];
#pragma unroll
    for (int e = 0; e < 8; ++e) { g1[e] = kg[64 + 8 * half + e]; g2[e] = kg[80 + 8 * half + e]; }
#pragma unroll
    for (int r = 0; r < R; ++r) { const int row = m0 + r * mstride;
        float x[16], x1[8], x2[8], cs[8], sn[8];
        { float a[8], b[8]; unpack8(n0[r], a); unpack8(n1[r], b);
#pragma unroll
          for (int e = 0; e < 8; ++e) { x[e] = a[e]; x[8 + e] = b[e]; } }
#pragma unroll
        for (int e = 0; e < 4; ++e) { x1[e] = ka[r][e]; x1[4 + e] = kb[r][e]; x2[e] = kc[r][e]; x2[4 + e] = kd[r][e]; cs[e] = ca[r][e]; cs[4 + e] = cb2[r][e]; sn[e] = sa[r][e]; sn[4 + e] = sb[r][e]; }
        float sn_ = 0.f, sr_ = 0.f;
#pragma unroll
        for (int e = 0; e < 16; ++e) sn_ += x[e] * x[e];
#pragma unroll
        for (int e = 0; e < 8; ++e) sr_ += x1[e] * x1[e] + x2[e] * x2[e];
        sn_ += __shfl_xor(sn_, 1); sn_ += __shfl_xor(sn_, 2);
        sr_ += __shfl_xor(sr_, 1);
        const float tot_n = sn_ + __shfl(sr_, 2 * hn);
        const float tot_r = sr_ + __shfl(sn_, 4 * hr);
        const float rn = 1.0f / sqrtf(tot_n * (1.0f / 96.0f) + EPS), rr = 1.0f / sqrtf(tot_r * (1.0f / 96.0f) + EPS);
        if (row < M_TOK) {
            bf16_t* out = KB + (size_t)row * 1536;
            { float a[8], b[8];
#pragma unroll
              for (int e = 0; e < 8; ++e) { a[e] = x[e] * rn * gn[e]; b[e] = x[8 + e] * rn * gn[8 + e]; }
              v4u* op = (v4u*)(out + hn * 96 + part * 16); op[0] = pack8(a); op[1] = pack8(b); }
            { float o1[8], o2[8];
#pragma unroll
              for (int e = 0; e < 8; ++e) { const float y1 = x1[e] * rr * g1[e], y2 = x2[e] * rr * g2[e]; o1[e] = y1 * cs[e] - y2 * sn[e]; o2[e] = y1 * sn[e] + y2 * cs[e]; }
              if (lane < 32) { *(v4u*)(out + hr * 96 + 64 + 8 * half) = pack8(o1); *(v4u*)(out + hr * 96 + 80 + 8 * half) = pack8(o2); } }
        } }
}
__device__ __forceinline__ void kbuild_tile(const bf16_t* SKV, const float* KRB, const float* kg, const float* ROPE, bf16_t* KB, int pm, int pn) {
    const int lane = threadIdx.x & 63, w = threadIdx.x >> 6;
    const int row = 256 * pm + 32 * w + (lane & 31), h = 2 * pn + (lane >> 5);
    const v4u* np = (const v4u*)(SKV + (size_t)row * 2048 + h * 128);
    const v4f* kr4 = (const v4f*)(KRB + (size_t)row * 32); const v4f* rp4 = (const v4f*)(ROPE + (size_t)(row % SEQ) * 32);
    v4u nv[8]; v4f kr[8], rp[8];
#pragma unroll
    for (int i = 0; i < 8; ++i) { nv[i] = np[i]; kr[i] = kr4[i]; rp[i] = rp4[i]; }
    float ss = 0.f;
#pragma unroll
    for (int i = 0; i < 8; ++i) { float x[8]; unpack8(nv[i], x);
#pragma unroll
        for (int e = 0; e < 8; ++e) ss += x[e] * x[e];
        ss += (kr[i][0] * kr[i][0] + kr[i][1] * kr[i][1]) + (kr[i][2] * kr[i][2] + kr[i][3] * kr[i][3]); }
    const float rn = 1.0f / sqrtf(ss * (1.0f / 96.0f) + EPS);
    v4u* out = (v4u*)(KB + (size_t)row * 1536 + h * 96);
#pragma unroll
    for (int i = 0; i < 8; ++i) { float x[8]; unpack8(nv[i], x);
#pragma unroll
        for (int e = 0; e < 8; ++e) x[e] = x[e] * rn * kg[8 * i + e];
        out[i] = pack8(x); }
    float o1[16], o2[16];
#pragma unroll
    for (int i = 0; i < 16; ++i) { const float y1 = kr[i >> 2][i & 3] * rn * kg[64 + i], y2 = kr[4 + (i >> 2)][i & 3] * rn * kg[80 + i], cs = rp[i >> 2][i & 3], sn = rp[4 + (i >> 2)][i & 3];
        o1[i] = y1 * cs - y2 * sn; o2[i] = y1 * sn + y2 * cs; }
    { float a[8];
#pragma unroll
      for (int e = 0; e < 8; ++e) a[e] = o1[e];
      out[8] = pack8(a);
#pragma unroll
      for (int e = 0; e < 8; ++e) a[e] = o1[8 + e];
      out[9] = pack8(a);
#pragma unroll
      for (int e = 0; e < 8; ++e) a[e] = o2[e];
      out[10] = pack8(a);
#pragma unroll
      for (int e = 0; e < 8; ++e) a[e] = o2[8 + e];
      out[11] = pack8(a); }
}
struct KOrder { pg8::StaticOrder so; const bf16_t* SKV; const float* KRB; const float* kg; const float* ROPE; bf16_t* KB;
    __device__ __forceinline__ bool next(int i, pg8::Unit& u) const { return so.next(i, u); }
    __device__ __forceinline__ void a_ready(const pg8::Unit&) const {}
    __device__ __forceinline__ void done(const pg8::Unit& u) const {
        asm volatile("s_waitcnt vmcnt(0)" ::: "memory");
        __builtin_amdgcn_s_barrier();
        asm volatile("" ::: "memory");
        kbuild_tile(SKV, KRB, kg, ROPE, KB, u.pm, u.pn);
    }
};
__device__ __forceinline__ void idx_rope64(v4u (&v)[8], const v4f (&rp)[8]) {
    float a[16], b[16];
    { float x[8]; unpack8(v[4], x);
#pragma unroll
      for (int e = 0; e < 8; ++e) a[e] = x[e];
      unpack8(v[5], x);
#pragma unroll
      for (int e = 0; e < 8; ++e) a[8 + e] = x[e];
      unpack8(v[6], x);
#pragma unroll
      for (int e = 0; e < 8; ++e) b[e] = x[e];
      unpack8(v[7], x);
#pragma unroll
      for (int e = 0; e < 8; ++e) b[8 + e] = x[e]; }
    float o1[16], o2[16];
#pragma unroll
    for (int i = 0; i < 16; ++i) { const float cs = rp[i >> 2][i & 3], sn = rp[4 + (i >> 2)][i & 3]; o1[i] = a[i] * cs - b[i] * sn; o2[i] = a[i] * sn + b[i] * cs; }
    { float x[8];
#pragma unroll
      for (int e = 0; e < 8; ++e) x[e] = o1[e];
      v[4] = pack8(x);
#pragma unroll
      for (int e = 0; e < 8; ++e) x[e] = o1[8 + e];
      v[5] = pack8(x);
#pragma unroll
      for (int e = 0; e < 8; ++e) x[e] = o2[e];
      v[6] = pack8(x);
#pragma unroll
      for (int e = 0; e < 8; ++e) x[e] = o2[8 + e];
      v[7] = pack8(x); }
}
__device__ __forceinline__ void idxpost_tile(const bf16_t* SI, const float* kig, const float* ROPE, bf16_t* QI, bf16_t* KI, float* WI, int pm, int t) {
    int tid = threadIdx.x; asm volatile("" : "+v"(tid));
    if (t < 2) {
        for (int k = 0; k < 2; ++k) { const int i = tid + 512 * k, row = 256 * pm + (i & 255), hl = i >> 8;
            const v4u* sp = (const v4u*)(SI + (size_t)row * 768 + 256 * t + 64 * hl); const v4f* r4 = (const v4f*)(ROPE + (size_t)(row % SEQ) * 32);
            v4u v[8]; v4f rp[8];
#pragma unroll
            for (int j = 0; j < 8; ++j) { v[j] = sp[j]; rp[j] = r4[j]; }
            idx_rope64(v, rp);
            v4u* op = (v4u*)(QI + (size_t)row * 512 + (4 * t + hl) * 64);
#pragma unroll
            for (int j = 0; j < 8; ++j) op[j] = v[j]; }
    } else if (tid < 256) {
        const int row = 256 * pm + tid, pos = row % SEQ;
        const v4u* sp = (const v4u*)(SI + (size_t)row * 768 + 512); const v4f* r4 = (const v4f*)(ROPE + (size_t)pos * 32);
        v4u v[8]; v4f rp[8];
#pragma unroll
        for (int j = 0; j < 8; ++j) { v[j] = sp[j]; rp[j] = r4[j]; }
        const v4u wv = sp[8];
        float ss = 0.f;
#pragma unroll
        for (int j = 0; j < 8; ++j) { float x[8]; unpack8(v[j], x);
#pragma unroll
            for (int e = 0; e < 8; ++e) ss += x[e] * x[e]; }
        const float r = 1.0f / sqrtf(ss * (1.0f / 64.0f) + EPS);
#pragma unroll
        for (int j = 0; j < 8; ++j) { float x[8]; unpack8(v[j], x);
#pragma unroll
            for (int e = 0; e < 8; ++e) x[e] = x[e] * r * kig[8 * j + e];
            v[j] = pack8(x); }
        idx_rope64(v, rp);
#pragma unroll
        for (int j = 0; j < 8; ++j) *(v4u*)(KI + (size_t)(row - pos) * 64 + (size_t)(((pos >> 5) * 4 + (j >> 1)) * 64 + (j & 1) * 32 + (pos & 31)) * 8) = v[j];
        { float x[8]; unpack8(wv, x); v4f* wp = (v4f*)(WI + (size_t)row * 8); wp[0] = (v4f){x[0], x[1], x[2], x[3]}; wp[1] = (v4f){x[4], x[5], x[6], x[7]}; }
    }
}
constexpr size_t IDX_OFF_SI = 0, IDX_OFF_QI = (size_t)216 << 20, IDX_OFF_KI = (size_t)232 << 20, IDX_OFF_WI = (size_t)234 << 20;
struct IdxOrder { pg8::StaticOrder so; unsigned char* big; const float* kig; const float* ROPE; int first;
    __device__ __forceinline__ bool next(int i, pg8::Unit& u) const { return so.next(i, u); }
    __device__ __forceinline__ void a_ready(const pg8::Unit&) const {}
    __device__ __forceinline__ void done(const pg8::Unit& u) const {
        if (u.pn < first) return;
        asm volatile("s_waitcnt vmcnt(0)" ::: "memory");
        __builtin_amdgcn_s_barrier();
        asm volatile("" ::: "memory");
        unsigned char* b = big; asm volatile("" : "+s"(b));
        idxpost_tile((const bf16_t*)(b + IDX_OFF_SI), kig, ROPE, (bf16_t*)(b + IDX_OFF_QI), (bf16_t*)(b + IDX_OFF_KI), (float*)(b + IDX_OFF_WI), u.pm, u.pn - first);
    }
};
struct FfnConv { const float* wup; const float* wdn; const float* gffn; unsigned char* wup_dst; unsigned char* wdn_dst; LAS unsigned char* lds; int gw, NGW, lane, wave, sel;
    __device__ __forceinline__ void operator()(int k) const {
        if (k != sel) return;
        __syncthreads();
        int gw_ = gw, lane_ = lane; asm volatile("" : "+v"(lane_)); asm volatile("" : "+s"(gw_));
        LAS float* scr = (LAS float*)(lds + wave * 16384);
        for (int it = gw_; it < 16 * (UPW / 32); it += NGW) tr_item(wup, 1024, UPW, (bf16_t*)wup_dst, scr, it, UPW / 32, lane_, gffn, -1);
        for (int it = gw_; it < (D_FF / 64) * 32; it += NGW) tr_item(wdn, D_FF, 1024, (bf16_t*)wdn_dst, scr, it, 32, lane_, nullptr, 0);
        __syncthreads();
    }
};
__device__ __forceinline__ void convgate_tile(const bf16_t* U, const float* cw, const float* cb, bf16_t* ACT, int pm, int pn) {
    const int lane = threadIdx.x & 63, w = threadIdx.x >> 6, cg = lane & 31, hf = lane >> 5;
    const int rs = 256 * pm + 32 * w + 16 * hf, ch = 128 * pn + 4 * cg, ucol = 256 * pn + 4 * cg;
    v4f wg[3], wv[3];
#pragma unroll
    for (int j = 0; j < 3; ++j) { wg[j] = *(const v4f*)(cw + j * UPW + ch) * -1.4426950408889634f; wv[j] = *(const v4f*)(cw + j * UPW + D_FF + ch) * -0.6931471805599453f; }
    const v4f bg = *(const v4f*)(cb + ch) * -1.4426950408889634f, bv = *(const v4f*)(cb + D_FF + ch) * -0.6931471805599453f;
    const bool seqstart = (rs % SEQ) == 0, skip2 = (w == 0) && (hf == 0) && !seqstart;
    v2u ga[18], va[18];
#pragma unroll
    for (int t = 0; t < 18; ++t) { ga[t] = (v2u){0u, 0u}; va[t] = ga[t]; }
    if (!seqstart) {
#pragma unroll
        for (int t = 0; t < 2; ++t) { ga[t] = *(const v2u*)(U + (size_t)(rs - 2 + t) * UPW + ucol); va[t] = *(const v2u*)(U + (size_t)(rs - 2 + t) * UPW + 128 + ucol); } }
#pragma unroll
    for (int t = 2; t < 18; ++t) { ga[t] = *(const v2u*)(U + (size_t)(rs - 2 + t) * UPW + ucol); va[t] = *(const v2u*)(U + (size_t)(rs - 2 + t) * UPW + 128 + ucol); }
#pragma unroll
    for (int t = 0; t < 16; ++t) {
        v4f go = bg, vo = bv;
#pragma unroll
        for (int j = 0; j < 3; ++j) { const v2u a = ga[t + j], c = va[t + j];
            go += wg[j] * (v4f){bflo(a.x), bfhi(a.x), bflo(a.y), bfhi(a.y)}; vo += wv[j] * (v4f){bflo(c.x), bfhi(c.x), bflo(c.y), bfhi(c.y)}; }
        float o[4];
#pragma unroll
        for (int e = 0; e < 4; ++e) { const float gg = go[e]; o[e] = gg * vo[e] * __builtin_amdgcn_rcpf(1.0f + __builtin_amdgcn_exp2f(gg)); }
        v2u wd; wd.x = pk2(o[0], o[1]); wd.y = pk2(o[2], o[3]);
        if (!(skip2 && t < 2)) *(v2u*)(ACT + (size_t)(rs + t) * D_FF + ch) = wd;
    }
}
__device__ __forceinline__ void convfix_item(const bf16_t* U, const float* cw, const float* cb, bf16_t* ACT, int item, int lane) {
    const int cbk = item % 11, rp = item / 11;
    const int t = rp & 1, k = rp >> 1, pm = k + 1 + (k / 31);
    const int r = 256 * pm + t, ch = cbk * 256 + 4 * lane, ucol = 256 * (ch >> 7) + (ch & 127);
    v4f go = *(const v4f*)(cb + ch), vo = *(const v4f*)(cb + D_FF + ch);
#pragma unroll
    for (int j = 0; j < 3; ++j) { const v4f wgj = *(const v4f*)(cw + j * UPW + ch), wvj = *(const v4f*)(cw + j * UPW + D_FF + ch);
        const v2u a = *(const v2u*)(U + (size_t)(r - 2 + j) * UPW + ucol), c = *(const v2u*)(U + (size_t)(r - 2 + j) * UPW + 128 + ucol);
        go += wgj * (v4f){bflo(a.x), bfhi(a.x), bflo(a.y), bfhi(a.y)}; vo += wvj * (v4f){bflo(c.x), bfhi(c.x), bflo(c.y), bfhi(c.y)}; }
    float o[4];
#pragma unroll
    for (int e = 0; e < 4; ++e) { const float gg = go[e]; o[e] = gg * __builtin_amdgcn_rcpf(1.0f + __builtin_amdgcn_exp2f(-1.4426950408889634f * gg)) * vo[e]; }
    v2u wd; wd.x = pk2(o[0], o[1]); wd.y = pk2(o[2], o[3]);
    *(v2u*)(ACT + (size_t)r * D_FF + ch) = wd;
}
struct DownOrder { pg8::StaticOrder so; const bf16_t* U; const float* cw; const float* cb; bf16_t* ACT;
    __device__ __forceinline__ bool next(int i, pg8::Unit& u) const { return so.next(i, u); }
    __device__ __forceinline__ void done(const pg8::Unit&) const {}
    __device__ __forceinline__ void a_ready(const pg8::Unit& u) const {
        if ((u.pm & 31) != 0) {
            for (int i = threadIdx.x; i < 2 * 704; i += NTHR) { const int t = i / 704, ch = 4 * (i % 704), r = 256 * u.pm + t, ucol = 256 * (ch >> 7) + (ch & 127);
                v4f go = *(const v4f*)(cb + ch), vo = *(const v4f*)(cb + D_FF + ch);
#pragma unroll
                for (int j = 0; j < 3; ++j) { const v4f wgj = *(const v4f*)(cw + j * UPW + ch), wvj = *(const v4f*)(cw + j * UPW + D_FF + ch);
                    const v2u a = *(const v2u*)(U + (size_t)(r - 2 + j) * UPW + ucol), c = *(const v2u*)(U + (size_t)(r - 2 + j) * UPW + 128 + ucol);
                    go += wgj * (v4f){bflo(a.x), bfhi(a.x), bflo(a.y), bfhi(a.y)}; vo += wvj * (v4f){bflo(c.x), bfhi(c.x), bflo(c.y), bfhi(c.y)}; }
                float o[4];
#pragma unroll
                for (int e = 0; e < 4; ++e) { const float gg = go[e]; o[e] = gg * __builtin_amdgcn_rcpf(1.0f + __builtin_amdgcn_exp2f(-1.4426950408889634f * gg)) * vo[e]; }
                v2u wd; wd.x = pk2(o[0], o[1]); wd.y = pk2(o[2], o[3]);
                *(v2u*)(ACT + (size_t)r * D_FF + ch) = wd; }
            asm volatile("s_waitcnt vmcnt(0)" ::: "memory");
        }
        __builtin_amdgcn_s_barrier();
        asm volatile("" ::: "memory");
    }
};
struct ConvOrder { pg8::StaticOrder so; const bf16_t* U; const float* cw; const float* cb; bf16_t* ACT; mutable int ppm, ppn;
    __device__ __forceinline__ bool next(int i, pg8::Unit& u) const { return so.next(i, u); }
    __device__ __forceinline__ void a_ready(const pg8::Unit&) const {}
    __device__ __forceinline__ void done(const pg8::Unit& u) const {
        if (ppm >= 0) {
            asm volatile("s_waitcnt vmcnt(48)\n\ts_barrier" ::: "memory");
            convgate_tile(U, cw, cb, ACT, ppm, ppn);
        }
        ppm = u.pm; ppn = u.pn;
    }
    __device__ __forceinline__ void flush() const {
        if (ppm >= 0) { asm volatile("s_waitcnt vmcnt(0)" ::: "memory"); __builtin_amdgcn_s_barrier(); asm volatile("" ::: "memory"); convgate_tile(U, cw, cb, ACT, ppm, ppn); ppm = -1; }
    }
};
__device__ __forceinline__ void convgate_item(const bf16_t* U, const float* cw, const float* cb, bf16_t* ACT, int item, int lane) {
    const int rb = item / 11, cbk = item % 11, r0 = rb * 32, c0 = cbk * 256 + 4 * lane;
    v4f wg[3], wv[3];
#pragma unroll
    for (int j = 0; j < 3; ++j) { wg[j] = *(const v4f*)(cw + j * UPW + c0); wv[j] = *(const v4f*)(cw + j * UPW + D_FF + c0); }
    const v4f bg = *(const v4f*)(cb + c0), bv = *(const v4f*)(cb + D_FF + c0);
    v4f g2 = {0.f, 0.f, 0.f, 0.f}, g1 = g2, v2 = g2, v1 = g2;
    if ((r0 % SEQ) != 0) {
        const v2u a = *(const v2u*)(U + (size_t)(r0 - 2) * UPW + c0), b = *(const v2u*)(U + (size_t)(r0 - 1) * UPW + c0);
        const v2u c = *(const v2u*)(U + (size_t)(r0 - 2) * UPW + D_FF + c0), d = *(const v2u*)(U + (size_t)(r0 - 1) * UPW + D_FF + c0);
        g2 = (v4f){bflo(a.x), bfhi(a.x), bflo(a.y), bfhi(a.y)}; g1 = (v4f){bflo(b.x), bfhi(b.x), bflo(b.y), bfhi(b.y)};
        v2 = (v4f){bflo(c.x), bfhi(c.x), bflo(c.y), bfhi(c.y)}; v1 = (v4f){bflo(d.x), bfhi(d.x), bflo(d.y), bfhi(d.y)};
    }
#pragma unroll
    for (int t = 0; t < 32; ++t) {
        const v2u a = *(const v2u*)(U + (size_t)(r0 + t) * UPW + c0), c = *(const v2u*)(U + (size_t)(r0 + t) * UPW + D_FF + c0);
        const v4f g0 = (v4f){bflo(a.x), bfhi(a.x), bflo(a.y), bfhi(a.y)}, v0 = (v4f){bflo(c.x), bfhi(c.x), bflo(c.y), bfhi(c.y)};
        const v4f go = bg + wg[0] * g2 + wg[1] * g1 + wg[2] * g0, vo = bv + wv[0] * v2 + wv[1] * v1 + wv[2] * v0;
        float o[4];
#pragma unroll
        for (int e = 0; e < 4; ++e) { const float gg = go[e]; o[e] = gg * __builtin_amdgcn_rcpf(1.0f + __builtin_amdgcn_exp2f(-1.4426950408889634f * gg)) * vo[e]; }
        v2u w; w.x = pk2(o[0], o[1]); w.y = pk2(o[2], o[3]);
        *(v2u*)(ACT + (size_t)(r0 + t) * D_FF + c0) = w;
        g2 = g1; g1 = g0; v2 = v1; v1 = v0;
    }
}

namespace att {
typedef short bf16x8 __attribute__((ext_vector_type(8)));
typedef short s16x4 __attribute__((ext_vector_type(4)));
typedef float f32x16 __attribute__((ext_vector_type(16)));
typedef float f32x2_t __attribute__((ext_vector_type(2)));
typedef __bf16 bf16x2_t __attribute__((ext_vector_type(2)));
__device__ __forceinline__ unsigned cvtpk(float lo, float hi) { f32x2_t v = {lo, hi}; bf16x2_t b = __builtin_convertvector(v, bf16x2_t); return __builtin_bit_cast(unsigned, b); }
__device__ __forceinline__ float fadd_s(float a, float b) { float r; asm("v_add_f32_e32 %0, %1, %2" : "=v"(r) : "v"(a), "v"(b)); return r; }
template <int C> __device__ __forceinline__ float mask_keep_c(float p, unsigned w) { unsigned t; float r;
    asm("v_bfe_i32 %0, %2, %4, 1\n\tv_and_b32_e32 %1, %0, %3" : "=&v"(t), "=v"(r) : "v"(w), "v"(p), "n"(C)); return r; }
__device__ __forceinline__ s16x4 vtr(const LAS unsigned char* p) { typedef short v4i16_t __attribute__((ext_vector_type(4))); return __builtin_bit_cast(s16x4, __builtin_amdgcn_ds_read_tr16_b64_v4i16((LAS v4i16_t*)p)); }
constexpr int VSTR = 192;
constexpr int TBL_N = 384, TBL_OFF = 320;
constexpr float LOG2E = 1.4426950408889634f;

__device__ __forceinline__ void bq_load(bf16x8 (&qr)[6], const bf16_t* SQ, size_t row, int pos, int h, int hi, const float* qg, const float* ROPE) {
    const bf16_t* qp = SQ + row * 1536 + h * 96 + 8 * hi;
    float x[6][8]; float ss = 0.f;
#pragma unroll
    for (int d0 = 0; d0 < 6; ++d0) { unpack8(*(const v4u*)(qp + 16 * d0), x[d0]);
#pragma unroll
        for (int e = 0; e < 8; ++e) ss += x[d0][e] * x[d0][e]; }
    ss += __shfl_xor(ss, 32);
    const float rn = (0.10206207261596577f * LOG2E) / sqrtf(ss * (1.0f / 96.0f) + EPS);
    const float* rp = ROPE + pos * 32 + 8 * hi;
#pragma unroll
    for (int d0 = 0; d0 < 6; ++d0) {
#pragma unroll
        for (int e = 0; e < 8; ++e) x[d0][e] = x[d0][e] * rn * qg[16 * d0 + 8 * hi + e]; }
#pragma unroll
    for (int e = 0; e < 8; ++e) { const float cs = rp[e], sn = rp[16 + e], y1 = x[4][e], y2 = x[5][e]; x[4][e] = y1 * cs - y2 * sn; x[5][e] = y1 * sn + y2 * cs; }
#pragma unroll
    for (int d0 = 0; d0 < 6; ++d0) qr[d0] = __builtin_bit_cast(bf16x8, pack8(x[d0]));
}
template <int DQK> struct Geo { static constexpr int KSTR = DQK * 2 + 16, KBUF = 64 * KSTR, VBUF = 64 * VSTR, NKC = DQK / 8, K0 = 0, V0 = 2 * KBUF, TBL = V0 + 2 * VBUF, BYTES = TBL + TBL_N * 4; };

template <int DQK, int MODE>
__device__ __forceinline__ void attn_unit(LAS unsigned char* lds, const bf16_t* __restrict__ Q, const bf16_t* __restrict__ K, const bf16_t* __restrict__ V, bf16_t* __restrict__ O,
                                          const unsigned* __restrict__ MASK, const float* __restrict__ bias, const float* __restrict__ gq, const float* __restrict__ gk, int b, int h, int qt) {
    typedef Geo<DQK> G;
    constexpr int PQ = 16 * DQK;
    const int tid = threadIdx.x, lane = tid & 63, r32 = lane & 31, hi = lane >> 5; const int wid = __builtin_amdgcn_readfirstlane(tid >> 6);
    const size_t rowbase = (size_t)b * SEQ;
    const int tq0 = qt * 256 + wid * 32;
    const int posq = tq0 + r32;
    const int cw = tq0 >> 6, lim_w = (cw + 1) * 64;
    const int j1 = 4 * qt + 3;
    int j0 = 0; if (MODE == 2) { j0 = 4 * qt - 8; if (j0 < 0) j0 = 0; }
    const int jw0 = (MODE == 2) ? (cw - 8) : 0;
    __syncthreads();
    if (MODE != 1) {
        LAS float* tbl = (LAS float*)(lds + G::TBL);
        for (int i = tid; i < TBL_N; i += NTHR) { const int rel = i - TBL_OFF; float v;
            if (MODE == 0) v = bias[t5_bucket(rel) * 16 + h];
            else { int dist = -rel; dist = dist < -63 ? -63 : (dist > 128 ? 128 : dist); v = bias[h * 192 + dist + 63]; }
            tbl[i] = v * LOG2E; }
    }
    float mref;
    { float a = fabsf(gq[lane]), c2 = fabsf(gk[lane]); if (DQK > 64 && lane < DQK - 64) { a = fmaxf(a, fabsf(gq[64 + lane])); c2 = fmaxf(c2, fabsf(gk[64 + lane])); }
#pragma unroll
      for (int o_ = 1; o_ < 64; o_ <<= 1) { a = fmaxf(a, __shfl_xor(a, o_)); c2 = fmaxf(c2, __shfl_xor(c2, o_)); }
      mref = sqrtf((float)DQK) * a * c2 * LOG2E * 1.02f + 0.5f;
      if (MODE == 0) { float mb = -1e30f; for (int i = 0; i < 32; ++i) mb = fmaxf(mb, bias[i * 16 + h]); mref += mb * LOG2E; }
      if (MODE == 2) { float mb = -1e30f; for (int i = lane; i < 192; i += 64) mb = fmaxf(mb, bias[h * 192 + i]);
#pragma unroll
          for (int o_ = 1; o_ < 64; o_ <<= 1) mb = fmaxf(mb, __shfl_xor(mb, o_));
          mref += mb * LOG2E; } }
    bf16x8 qr[DQK / 16];
    if constexpr (MODE == 1) bq_load(qr, Q, rowbase + posq, posq, h, hi, gq, bias);
    else { const bf16_t* qp = Q + (rowbase + posq) * PQ + h * DQK + 8 * hi;
#pragma unroll
        for (int d0 = 0; d0 < DQK / 16; ++d0) qr[d0] = *(const bf16x8*)(qp + 16 * d0); }
    constexpr int VP = MODE == 1 ? 2048 : 1024, VH = MODE == 1 ? 128 : 64;
    const bf16_t* Kh = K + rowbase * PQ + h * DQK; const bf16_t* Vh = V + rowbase * VP + h * VH;
    const int kc0 = tid, kc1 = tid + 512; const bool has1 = (G::NKC * 64 > 512) && (kc1 < G::NKC * 64);
    const int kr0 = kc0 / G::NKC, kp0 = kc0 % G::NKC, kr1 = kc1 / G::NKC, kp1 = kc1 % G::NKC;
    const int vr = tid >> 3, vp = tid & 7;
    v4u kreg0, kreg1 = {0u, 0u, 0u, 0u}, vreg; v2u mnext = {0u, 0u};
    const unsigned* mrow = MASK ? (MASK + (rowbase + posq) * 256) : nullptr;
#define ATT_LOAD(j) do { const size_t kv0 = (size_t)(j) * 64; \
        kreg0 = *(const v4u*)(Kh + (kv0 + kr0) * PQ + kp0 * 8); if (has1) kreg1 = *(const v4u*)(Kh + (kv0 + kr1) * PQ + kp1 * 8); \
        vreg = *(const v4u*)(Vh + (kv0 + vr) * VP + vp * 8); if (MODE == 0) mnext = *(const v2u*)(mrow + 2 * (j)); } while (0)
    ATT_LOAD(j0);
    float l = 0.f; f32x16 o[2];
#pragma unroll
    for (int i = 0; i < 16; ++i) { o[0][i] = 0.f; o[1][i] = 0.f; }
    const LAS unsigned char* kfrag = lds + G::K0 + r32 * G::KSTR + hi * 16;
    const LAS unsigned char* vfrag = lds + G::V0 + (4 * hi + ((lane & 15) >> 2)) * VSTR + (16 * ((lane >> 4) & 1) + 4 * (lane & 3)) * 2;
    for (int j = j0; j <= j1; ++j) {
        const int buf = (j - j0) & 1;
        *(LAS v4u*)(lds + G::K0 + buf * G::KBUF + kr0 * G::KSTR + kp0 * 16) = kreg0;
        if (has1) *(LAS v4u*)(lds + G::K0 + buf * G::KBUF + kr1 * G::KSTR + kp1 * 16) = kreg1;
        *(LAS v4u*)(lds + G::V0 + buf * G::VBUF + vr * VSTR + vp * 16) = vreg;
        const v2u mcur = mnext;
        __syncthreads();
        if (j < j1) ATT_LOAD(j + 1);
        const bool active = (64 * j < lim_w) && (j >= jw0);
        if (active) {
            float binit = -mref;
            bool far = false;
            if (MODE != 1) { const LAS float* tbl = (const LAS float*)(lds + G::TBL); far = (64 * j + 63 - tq0) <= -128; if (far) binit += tbl[0]; }
            f32x16 s0, s1;
#pragma unroll
            for (int i = 0; i < 16; ++i) { s0[i] = binit; s1[i] = binit; }
            const LAS unsigned char* kb = kfrag + buf * G::KBUF;
#pragma unroll
            for (int d0 = 0; d0 < DQK / 16; ++d0) {
                const bf16x8 k0 = *(const LAS bf16x8*)(kb + d0 * 32), k1 = *(const LAS bf16x8*)(kb + 32 * G::KSTR + d0 * 32);
                s0 = __builtin_amdgcn_mfma_f32_32x32x16_bf16(k0, qr[d0], s0, 0, 0, 0);
                s1 = __builtin_amdgcn_mfma_f32_32x32x16_bf16(k1, qr[d0], s1, 0, 0, 0);
            }
            if (MODE != 1 && !far) { const LAS float* tp = (const LAS float*)(lds + G::TBL) + (64 * j - posq + 4 * hi + TBL_OFF);
#pragma unroll
                for (int i = 0; i < 16; ++i) { const int c = (i & 3) + 8 * (i >> 2); s0[i] += tp[c]; s1[i] += tp[c + 32]; }
            }
#pragma unroll
            for (int i = 0; i < 16; ++i) { s0[i] = __builtin_amdgcn_exp2f(s0[i]); s1[i] = __builtin_amdgcn_exp2f(s1[i]); }
            if (MODE == 0) {
                const unsigned w0 = mcur.x >> (4 * hi), w1 = mcur.y >> (4 * hi);
                s0[0] = mask_keep_c<0>(s0[0], w0); s1[0] = mask_keep_c<0>(s1[0], w1);
                s0[1] = mask_keep_c<1>(s0[1], w0); s1[1] = mask_keep_c<1>(s1[1], w1);
                s0[2] = mask_keep_c<2>(s0[2], w0); s1[2] = mask_keep_c<2>(s1[2], w1);
                s0[3] = mask_keep_c<3>(s0[3], w0); s1[3] = mask_keep_c<3>(s1[3], w1);
                s0[4] = mask_keep_c<8>(s0[4], w0); s1[4] = mask_keep_c<8>(s1[4], w1);
                s0[5] = mask_keep_c<9>(s0[5], w0); s1[5] = mask_keep_c<9>(s1[5], w1);
                s0[6] = mask_keep_c<10>(s0[6], w0); s1[6] = mask_keep_c<10>(s1[6], w1);
                s0[7] = mask_keep_c<11>(s0[7], w0); s1[7] = mask_keep_c<11>(s1[7], w1);
                s0[8] = mask_keep_c<16>(s0[8], w0); s1[8] = mask_keep_c<16>(s1[8], w1);
                s0[9] = mask_keep_c<17>(s0[9], w0); s1[9] = mask_keep_c<17>(s1[9], w1);
                s0[10] = mask_keep_c<18>(s0[10], w0); s1[10] = mask_keep_c<18>(s1[10], w1);
                s0[11] = mask_keep_c<19>(s0[11], w0); s1[11] = mask_keep_c<19>(s1[11], w1);
                s0[12] = mask_keep_c<24>(s0[12], w0); s1[12] = mask_keep_c<24>(s1[12], w1);
                s0[13] = mask_keep_c<25>(s0[13], w0); s1[13] = mask_keep_c<25>(s1[13], w1);
                s0[14] = mask_keep_c<26>(s0[14], w0); s1[14] = mask_keep_c<26>(s1[14], w1);
                s0[15] = mask_keep_c<27>(s0[15], w0); s1[15] = mask_keep_c<27>(s1[15], w1);
            }
            { float ps0 = s0[0] + s1[0], ps1 = s0[1] + s1[1];
              asm("" : "+v"(ps0)); asm("" : "+v"(ps1));
#pragma unroll
              for (int i = 2; i < 16; i += 2) { float t0 = s0[i] + s1[i]; asm("" : "+v"(t0)); float t1 = s0[i + 1] + s1[i + 1]; asm("" : "+v"(t1));
                  ps0 += t0; asm("" : "+v"(ps0)); ps1 += t1; asm("" : "+v"(ps1)); }
              l += ps0 + ps1; }
            const LAS unsigned char* vb = vfrag + buf * G::VBUF;
#pragma unroll
            for (int blk = 0; blk < 2; ++blk)
#pragma unroll
                for (int s = 0; s < 2; ++s) {
                    v4u pw;
                    if (blk == 0) { pw.x = cvtpk(s0[8 * s + 0], s0[8 * s + 1]); pw.y = cvtpk(s0[8 * s + 2], s0[8 * s + 3]); pw.z = cvtpk(s0[8 * s + 4], s0[8 * s + 5]); pw.w = cvtpk(s0[8 * s + 6], s0[8 * s + 7]); }
                    else { pw.x = cvtpk(s1[8 * s + 0], s1[8 * s + 1]); pw.y = cvtpk(s1[8 * s + 2], s1[8 * s + 3]); pw.z = cvtpk(s1[8 * s + 4], s1[8 * s + 5]); pw.w = cvtpk(s1[8 * s + 6], s1[8 * s + 7]); }
                    const bf16x8 pf = __builtin_bit_cast(bf16x8, pw);
#pragma unroll
                    for (int dh = 0; dh < 2; ++dh) {
                        const s16x4 lo = vtr(vb + (32 * blk + 16 * s) * VSTR + dh * 64), hh = vtr(vb + (32 * blk + 16 * s + 8) * VSTR + dh * 64);
                        const bf16x8 vf = {lo[0], lo[1], lo[2], lo[3], hh[0], hh[1], hh[2], hh[3]};
                        o[dh] = __builtin_amdgcn_mfma_f32_32x32x16_bf16(vf, pf, o[dh], 0, 0, 0);
                    }
                }
        }
    }
#undef ATT_LOAD
    l += __shfl_xor(l, 32);
    const float inv = 1.0f / l;
    bf16_t* op = O + (rowbase + posq) * 1024 + h * 64 + 4 * hi;
#pragma unroll
    for (int dh = 0; dh < 2; ++dh)
#pragma unroll
        for (int g = 0; g < 4; ++g) { v2u w; w.x = cvtpk(o[dh][4 * g] * inv, o[dh][4 * g + 1] * inv); w.y = cvtpk(o[dh][4 * g + 2] * inv, o[dh][4 * g + 3] * inv);
            *(v2u*)(op + 32 * dh + 8 * g) = w; }
}
namespace pa { constexpr int NSLOT = 3, SLOTB = 8192, L_K = 0, L_V = NSLOT * SLOTB, L_WS = 2 * NSLOT * SLOTB, L_OST = L_WS + 8 * 64 * 4, L_TBL = L_OST + 8 * 4096, TBLN = 576, L_MSK = L_TBL + TBLN * 4, BYTES = L_MSK + 8 * 512; }
__device__ __forceinline__ void glds16(unsigned voff, const void* sbase, unsigned lds_dst) { unsigned keep;
    asm volatile("s_nop 4\n\ts_mov_b32 %0, m0\n\ts_mov_b32 m0, %3\n\ts_nop 0\n\tglobal_load_lds_dwordx4 %1, %2\n\ts_mov_b32 m0, %0" : "=&s"(keep) : "v"(voff), "s"(sbase), "s"(lds_dst) : "memory"); }
__device__ __forceinline__ void glds4(unsigned voff, const void* sbase, unsigned lds_dst) { unsigned keep;
    asm volatile("s_nop 4\n\ts_mov_b32 %0, m0\n\ts_mov_b32 m0, %3\n\ts_nop 0\n\tglobal_load_lds_dword %1, %2\n\ts_mov_b32 m0, %0" : "=&s"(keep) : "v"(voff), "s"(sbase), "s"(lds_dst) : "memory"); }
__device__ __forceinline__ void attn_unit_a(LAS unsigned char* lds, const bf16_t* Q, const bf16_t* K, const bf16_t* V, bf16_t* O, const unsigned* MASK, const float* bias, const float* gq, const float* gk, int b, int h, int qt, bool newhead) {
    using namespace pa;
    const int tid = threadIdx.x, lane = tid & 63, r32 = lane & 31, hi = lane >> 5; const int wid = __builtin_amdgcn_readfirstlane(tid >> 6);
    const size_t rowbase = (size_t)b * SEQ; const int q0 = qt * 256, tq0 = q0 + wid * 32, posq = tq0 + r32;
    const int cw = tq0 >> 6;
    const int NT = 4 * qt + 4;
    if (newhead) {
        const float bfar = bias[t5_bucket(-TBL_OFF) * 16 + h] * LOG2E;
        LAS float* tbl = (LAS float*)(lds + L_TBL);
        for (int i = tid; i < TBLN; i += NTHR) tbl[i] = bias[t5_bucket(i - TBL_OFF) * 16 + h] * LOG2E - bfar; }
    const f32x16 zc = {0.f, 0.f, 0.f, 0.f, 0.f, 0.f, 0.f, 0.f, 0.f, 0.f, 0.f, 0.f, 0.f, 0.f, 0.f, 0.f};
    const bf16_t* Kh = K + rowbase * 1024 + h * 64; const bf16_t* Vh = V + rowbase * 1024 + h * 64;
    const unsigned lds0 = (unsigned)(size_t)lds;
    const unsigned koff = (unsigned)(lane * 1024 + wid * 8) * 2u;
    const unsigned voff = (unsigned)((16 * (wid & 3) + (lane >> 2)) * 1024 + (wid >> 2) * 32 + (lane & 3) * 8) * 2u;
    const unsigned kdst = lds0 + L_K + wid * 1024, vdst = lds0 + L_V + wid * 1024;
    const unsigned* mbase = MASK + rowbase * 256; const unsigned moff = (unsigned)(tq0 + r32) * 1024u + 4u * (unsigned)hi; const unsigned mdst = lds0 + L_MSK + wid * 512;
    const LAS unsigned* mrd = (const LAS unsigned*)(lds + L_MSK + wid * 512) + r32;
#define DMA_K(t, slot) glds16(koff, (const char*)Kh + (size_t)(t) * 131072, (unsigned)__builtin_amdgcn_readfirstlane(kdst + (slot)))
#define DMA_V(t, slot) glds16(voff, (const char*)Vh + (size_t)(t) * 131072, (unsigned)__builtin_amdgcn_readfirstlane(vdst + (slot)))
#define MDMA(t) glds4(moff, mbase + 2 * (t), (unsigned)__builtin_amdgcn_readfirstlane(mdst + ((t) & 1) * 256))
#define SBAR() __builtin_amdgcn_sched_barrier(0)
#define PIN(x) asm volatile("" : "+v"(x))
#define WAIT_BAR(N) asm volatile("s_waitcnt vmcnt(" #N ") lgkmcnt(0)\n\ts_barrier" : : : "memory")
    const LAS unsigned char* kp0 = lds + L_K + hi * 1024 + r32 * 16;
    const LAS unsigned char* vp0 = lds + L_V + ((lane >> 4) & 1) * 32 + (lane & 3) * 8 + (4 * hi + ((lane & 15) >> 2)) * 64;
    LAS float* wsf = (LAS float*)(lds + L_WS) + wid * 64;
    const LAS float* tbl0 = (const LAS float*)(lds + L_TBL) + (4 * hi + TBL_OFF - posq);
    DMA_K(0, 0); DMA_V(0, 0); DMA_K(1, SLOTB);
    bf16x8 qr[4];
    { const bf16_t* qp = Q + (rowbase + posq) * 1024 + h * 64 + 8 * hi;
#pragma unroll
      for (int d0 = 0; d0 < 4; ++d0) qr[d0] = *(const bf16x8*)(qp + 16 * d0); }
    DMA_K(2, 2 * SLOTB); MDMA(0);
    float l_reg = 0.f; f32x16 o[2];
#pragma unroll
    for (int i = 0; i < 16; ++i) { o[0][i] = 0.f; o[1][i] = 0.f; }
    bf16x8 kf[8];
    f32x16 pA0, pA1, pB0, pB1;
    int sl_prev = 0, sl_cur = 0, sl_next = SLOTB;
#define ROT() do { sl_prev = sl_cur; sl_cur = sl_next; sl_next = (sl_next == (NSLOT - 1) * SLOTB) ? 0 : sl_next + SLOTB; } while (0)
#define KF(p) (*(const LAS bf16x8*)(p))
#define ADDBIAS(C0, C1, t) do { const LAS float* tp_ = tbl0 + 64 * (t); _Pragma("unroll") for (int r = 0; r < 16; ++r) { const int c_ = (r & 3) + 8 * (r >> 2); C0[r] += tp_[c_]; C1[r] += tp_[c_ + 32]; } } while (0)
    WAIT_BAR(4);
    { const LAS unsigned char* kb = kp0;
#pragma unroll
      for (int d0 = 0; d0 < 4; ++d0) { const bf16x8 b0 = KF(kb + d0 * 2048), b1 = KF(kb + d0 * 2048 + 512);
          if (d0 == 0) { pA0 = __builtin_amdgcn_mfma_f32_32x32x16_bf16(b0, qr[0], zc, 0, 0, 0); pA1 = __builtin_amdgcn_mfma_f32_32x32x16_bf16(b1, qr[0], zc, 0, 0, 0); }
          else { pA0 = __builtin_amdgcn_mfma_f32_32x32x16_bf16(b0, qr[d0], pA0, 0, 0, 0); pA1 = __builtin_amdgcn_mfma_f32_32x32x16_bf16(b1, qr[d0], pA1, 0, 0, 0); } }
      if (63 - tq0 > -128) ADDBIAS(pA0, pA1, 0);
#pragma unroll
      for (int r = 0; r < 16; ++r) { pA0[r] = __builtin_amdgcn_exp2f(pA0[r]); pA1[r] = __builtin_amdgcn_exp2f(pA1[r]); } }
    WAIT_BAR(0);
    DMA_K(3, 0); DMA_V(1, SLOTB); MDMA(1);
    ROT();
#pragma unroll
    for (int j = 0; j < 4; ++j) { kf[2 * j] = KF(kp0 + sl_cur + j * 2048); kf[2 * j + 1] = KF(kp0 + sl_cur + j * 2048 + 512); }
    WAIT_BAR(3);
    s16x4 vlo[8], vhi[8]; v4u pw0, pw1, pw2, pw3;
#define PAF(k) __builtin_bit_cast(bf16x8, pw##k)
#define VFR(i) (bf16x8){vlo[i][0], vlo[i][1], vlo[i][2], vlo[i][3], vhi[i][0], vhi[i][1], vhi[i][2], vhi[i][3]}
#define MFMA(a, b, c) __builtin_amdgcn_mfma_f32_32x32x16_bf16(a, b, c, 0, 0, 0)
#define MK4(X, B, w) do { X[B] = mask_keep_c<2 * (B)>(X[B], w); X[B + 1] = mask_keep_c<2 * (B) + 1>(X[B + 1], w); X[B + 2] = mask_keep_c<2 * (B) + 2>(X[B + 2], w); X[B + 3] = mask_keep_c<2 * (B) + 3>(X[B + 3], w); } while (0)
#define GAPA(MF, X, B, w, PW, H) do { MF; MK4(X, B, w); sacc0 += X[B]; sacc1 += X[B + 1]; sacc0 += X[B + 2]; sacc1 += X[B + 3]; PIN(sacc0); PIN(sacc1); \
        PW[2 * (H)] = cvtpk(X[B], X[B + 1]); PW[2 * (H) + 1] = cvtpk(X[B + 2], X[B + 3]); PIN(PW); SBAR(); } while (0)
#define EX(v) __builtin_amdgcn_exp2f(v)
#define GAPB(MF, X, B) do { MF; X[B] = EX(X[B]); X[B + 1] = EX(X[B + 1]); X[B + 2] = EX(X[B + 2]); X[B + 3] = EX(X[B + 3]); PIN(X); SBAR(); } while (0)
#define VRD(i) do { vlo[i] = vtr(vp_ + (((i) >> 2) * 4096 + ((i) & 3) * 1024)); vhi[i] = vtr(vp_ + (((i) >> 2) * 4096 + ((i) & 3) * 1024 + 512)); } while (0)
#define KRD(G, j) do { if (G) { kf[2 * (j)] = KF(kp0 + sl_next + (j) * 2048); kf[2 * (j) + 1] = KF(kp0 + sl_next + (j) * 2048 + 512); SBAR(); } } while (0)
#define STEP(C0, C1, P0, P1, t, GK, GV, GL, PEEL) do { SBAR(); \
        const LAS unsigned char* vp_ = vp0 + sl_prev; \
        v2u mu_; mu_.x = mrd[(((t) - 1) & 1) * 64]; mu_.y = mrd[(((t) - 1) & 1) * 64 + 32]; if (PEEL) { if ((t) - 1 > cw) { mu_.x = 0u; mu_.y = 0u; } } \
        const unsigned w0_ = mu_.x >> (4 * hi), w1_ = mu_.y >> (4 * hi); float sacc0 = 0.f, sacc1 = 0.f; \
        VRD(0); SBAR(); GAPA(C0 = MFMA(kf[0], qr[0], zc), P0, 0, w0_, pw0, 0); \
        VRD(4); SBAR(); GAPA(C1 = MFMA(kf[1], qr[0], zc), P0, 4, w0_, pw0, 1); \
        VRD(1); SBAR(); GAPA(C0 = MFMA(kf[2], qr[1], C0), P0, 8, w0_, pw1, 0); \
        VRD(5); SBAR(); GAPA(C1 = MFMA(kf[3], qr[1], C1), P0, 12, w0_, pw1, 1); \
        VRD(2); SBAR(); GAPA(C0 = MFMA(kf[4], qr[2], C0), P1, 0, w1_, pw2, 0); \
        VRD(6); SBAR(); GAPA(C1 = MFMA(kf[5], qr[2], C1), P1, 4, w1_, pw2, 1); \
        VRD(3); SBAR(); GAPA(C0 = MFMA(kf[6], qr[3], C0), P1, 8, w1_, pw3, 0); \
        VRD(7); SBAR(); GAPA(C1 = MFMA(kf[7], qr[3], C1), P1, 12, w1_, pw3, 1); \
        l_reg += sacc0 + sacc1; \
        if (GK) { DMA_K((t) + 3, sl_cur); } if (GV) { DMA_V((t) + 1, sl_next); MDMA((t) + 1); } \
        if (PEEL) { if (64 * (t) + 63 - tq0 > -128) ADDBIAS(C0, C1, t); } \
        SBAR(); \
        GAPB(o[0] = MFMA(PAF(0), VFR(0), o[0]), C0, 0); \
        GAPB(o[1] = MFMA(PAF(0), VFR(4), o[1]), C0, 4); \
        KRD(GL, 0); GAPB(o[0] = MFMA(PAF(1), VFR(1), o[0]), C0, 8); \
        KRD(GL, 1); GAPB(o[1] = MFMA(PAF(1), VFR(5), o[1]), C0, 12); \
        KRD(GL, 2); GAPB(o[0] = MFMA(PAF(2), VFR(2), o[0]), C1, 0); \
        KRD(GL, 3); GAPB(o[1] = MFMA(PAF(2), VFR(6), o[1]), C1, 4); \
        GAPB(o[0] = MFMA(PAF(3), VFR(3), o[0]), C1, 8); \
        GAPB(o[1] = MFMA(PAF(3), VFR(7), o[1]), C1, 12); \
    } while (0)
    int t = 1;
    for (; t + 7 < NT; t += 2) {
        STEP(pB0, pB1, pA0, pA1, t, true, true, true, false);     WAIT_BAR(3); ROT();
        STEP(pA0, pA1, pB0, pB1, t + 1, true, true, true, false); WAIT_BAR(3); ROT();
    }
#define ENDW(tt) do { if ((tt) + 3 < NT) { WAIT_BAR(3); } else if ((tt) + 2 < NT) { WAIT_BAR(2); } else { WAIT_BAR(0); } } while (0)
    for (; t + 1 < NT; t += 2) {
        STEP(pB0, pB1, pA0, pA1, t, (t + 3 < NT), (t + 1 < NT), (t + 1 < NT), true);     ENDW(t);     ROT();
        STEP(pA0, pA1, pB0, pB1, t + 1, (t + 4 < NT), (t + 2 < NT), (t + 2 < NT), true); ENDW(t + 1); ROT();
    }
    STEP(pB0, pB1, pA0, pA1, NT - 1, false, false, false, true);
    { v2u mu_; mu_.x = mrd[64]; mu_.y = mrd[64 + 32]; if (NT - 1 > cw) { mu_.x = 0u; mu_.y = 0u; }
      const unsigned w0_ = mu_.x >> (4 * hi), w1_ = mu_.y >> (4 * hi);
      MK4(pB0, 0, w0_); MK4(pB0, 4, w0_); MK4(pB0, 8, w0_); MK4(pB0, 12, w0_); MK4(pB1, 0, w1_); MK4(pB1, 4, w1_); MK4(pB1, 8, w1_); MK4(pB1, 12, w1_);
      float sacc = 0.f;
#pragma unroll
      for (int r = 0; r < 16; ++r) sacc += pB0[r] + pB1[r];
      l_reg += sacc;
      pw0 = (v4u){cvtpk(pB0[0], pB0[1]), cvtpk(pB0[2], pB0[3]), cvtpk(pB0[4], pB0[5]), cvtpk(pB0[6], pB0[7])};
      pw1 = (v4u){cvtpk(pB0[8], pB0[9]), cvtpk(pB0[10], pB0[11]), cvtpk(pB0[12], pB0[13]), cvtpk(pB0[14], pB0[15])};
      pw2 = (v4u){cvtpk(pB1[0], pB1[1]), cvtpk(pB1[2], pB1[3]), cvtpk(pB1[4], pB1[5]), cvtpk(pB1[6], pB1[7])};
      pw3 = (v4u){cvtpk(pB1[8], pB1[9]), cvtpk(pB1[10], pB1[11]), cvtpk(pB1[12], pB1[13]), cvtpk(pB1[14], pB1[15])};
      const LAS unsigned char* vp_ = vp0 + sl_cur;
#pragma unroll
      for (int i = 0; i < 8; ++i) { vlo[i] = vtr(vp_ + ((i >> 2) * 4096 + (i & 3) * 1024)); vhi[i] = vtr(vp_ + ((i >> 2) * 4096 + (i & 3) * 1024 + 512)); }
      o[0] = MFMA(PAF(0), VFR(0), o[0]); o[1] = MFMA(PAF(0), VFR(4), o[1]); o[0] = MFMA(PAF(1), VFR(1), o[0]); o[1] = MFMA(PAF(1), VFR(5), o[1]);
      o[0] = MFMA(PAF(2), VFR(2), o[0]); o[1] = MFMA(PAF(2), VFR(6), o[1]); o[0] = MFMA(PAF(3), VFR(3), o[0]); o[1] = MFMA(PAF(3), VFR(7), o[1]); }
    { const unsigned lu = __float_as_uint(l_reg); auto rr = __builtin_amdgcn_permlane32_swap(lu, lu, false, false); l_reg = __uint_as_float(rr[0]) + __uint_as_float(rr[1]); }
    if (hi == 0) wsf[32 + r32] = l_reg;
    asm volatile("s_waitcnt lgkmcnt(0)" : : : "memory");
    float rli[16];
#pragma unroll
    for (int r = 0; r < 16; ++r) rli[r] = __builtin_amdgcn_rcpf(wsf[32 + (r & 3) + 8 * (r >> 2) + 4 * hi]);
    bf16_t* Ow = O + (rowbase + q0 + wid * 32) * 1024 + h * 64;
    { LAS bf16_t* stg = (LAS bf16_t*)(lds + L_OST) + wid * 2048;
#pragma unroll
      for (int r = 0; r < 16; ++r) { const int orow = (r & 3) + 8 * (r >> 2) + 4 * hi;
#pragma unroll
          for (int d0 = 0; d0 < 2; ++d0) stg[orow * 64 + d0 * 32 + r32] = (bf16_t)cvtpk(o[d0][r] * rli[r], 0.f); }
      asm volatile("s_waitcnt lgkmcnt(0)" : : : "memory");
#pragma unroll
      for (int i = 0; i < 4; ++i) { const int row = i * 8 + (lane >> 3), ch = lane & 7; const v4u v = *(const LAS v4u*)(stg + row * 64 + ch * 8); *(v4u*)(Ow + (size_t)row * 1024 + ch * 8) = v; } }
    asm volatile("s_waitcnt lgkmcnt(0)\n\ts_barrier" : : : "memory");
#undef DMA_K
#undef DMA_V
#undef MDMA
#undef SBAR
#undef PIN
#undef WAIT_BAR
#undef ROT
#undef KF
#undef ADDBIAS
#undef PAF
#undef VFR
#undef MFMA
#undef MK4
#undef GAPA
#undef EX
#undef GAPB
#undef VRD
#undef KRD
#undef STEP
#undef ENDW
}
namespace pb { constexpr int NSLOT = 3, KSLOT = 12288, VSLOT = 8192, L_K = 0, L_V = 4 * KSLOT, L_WS = L_V + NSLOT * VSLOT, L_OST = L_WS + 8 * 64 * 4, BYTES = L_OST + 8 * 4096; }
__device__ __forceinline__ void attn_unit_b(LAS unsigned char* lds, const bf16_t* Q, const bf16_t* K, const bf16_t* V, bf16_t* O, const float* gq, const float* rope, int b, int h, int qt) {
    using namespace pb;
    const int tid = threadIdx.x, lane = tid & 63, r32 = lane & 31, hi = lane >> 5; const int wid = __builtin_amdgcn_readfirstlane(tid >> 6);
    const size_t rowbase = (size_t)b * SEQ; const int q0 = qt * 256, tq0 = q0 + wid * 32, posq = tq0 + r32;
    const int cw = tq0 >> 6;
    const int NT = 4 * qt + 4;
    const f32x16 zc = {0.f, 0.f, 0.f, 0.f, 0.f, 0.f, 0.f, 0.f, 0.f, 0.f, 0.f, 0.f, 0.f, 0.f, 0.f, 0.f};
    const bf16_t* Kh = K + rowbase * 1536 + h * 96; const bf16_t* Vh = V + rowbase * 2048 + h * 128;
    const unsigned lds0 = (unsigned)(size_t)lds;
    const unsigned koffA = (unsigned)(lane * 1536 + wid * 8) * 2u, koffB = (unsigned)(lane * 1536 + (8 + (wid & 3)) * 8) * 2u;
    const unsigned voff = (unsigned)((16 * (wid & 3) + (lane >> 2)) * 2048 + (wid >> 2) * 32 + (lane & 3) * 8) * 2u;
    const unsigned kdstA = lds0 + L_K + wid * 1024, kdstB = lds0 + L_K + (8 + (wid & 3)) * 1024, vdst = lds0 + L_V + wid * 1024;
#define RFL(x) ((unsigned)__builtin_amdgcn_readfirstlane(x))
#define DMA_K(t, sl) do { const char* kb_ = (const char*)Kh + (size_t)(t) * (64 * 1536 * 2); glds16(koffA, kb_, RFL(kdstA + (sl) * KSLOT)); glds16(koffB, kb_, RFL(kdstB + (sl) * KSLOT)); } while (0)
#define DMA_V(t, sl) glds16(voff, (const char*)Vh + (size_t)(t) * 262144, RFL(vdst + (sl) * VSLOT))
#define SBAR() __builtin_amdgcn_sched_barrier(0)
#define PIN(x) asm volatile("" : "+v"(x))
#define WAIT_BAR(N) asm volatile("s_waitcnt vmcnt(" #N ") lgkmcnt(0)\n\ts_barrier" : : : "memory")
    const LAS unsigned char* kp0 = lds + L_K + hi * 1024 + r32 * 16;
    const LAS unsigned char* vp0 = lds + L_V + ((lane >> 4) & 1) * 32 + (lane & 3) * 8 + (4 * hi + ((lane & 15) >> 2)) * 64;
    LAS float* wsf = (LAS float*)(lds + L_WS) + wid * 64;
    DMA_K(0, 0); DMA_V(0, 0); DMA_K(1, 1);
    bf16x8 qr[6];
    bq_load(qr, Q, rowbase + posq, posq, h, hi, gq, rope);
    DMA_K(2, 2);
    float l_reg = 0.f; f32x16 o[2];
#pragma unroll
    for (int i = 0; i < 16; ++i) { o[0][i] = 0.f; o[1][i] = 0.f; }
    bf16x8 kf[12];
    f32x16 pA0, pA1, pB0, pB1;
    int ks = 0, sl_prev = 0, sl_cur = 0, sl_next = 1;
#define ROT() do { ks = (ks + 1) & 3; sl_prev = sl_cur; sl_cur = sl_next; sl_next = (sl_next == NSLOT - 1) ? 0 : sl_next + 1; } while (0)
#define KF(p) (*(const LAS bf16x8*)(p))
#define MFMA(a, b, c) __builtin_amdgcn_mfma_f32_32x32x16_bf16(a, b, c, 0, 0, 0)
    WAIT_BAR(5);
    { const LAS unsigned char* kb = kp0;
#pragma unroll
      for (int d0 = 0; d0 < 6; ++d0) { const bf16x8 b0 = KF(kb + d0 * 2048), b1 = KF(kb + d0 * 2048 + 512);
          if (d0 == 0) { pA0 = MFMA(b0, qr[0], zc); pA1 = MFMA(b1, qr[0], zc); } else { pA0 = MFMA(b0, qr[d0], pA0); pA1 = MFMA(b1, qr[d0], pA1); } }
#pragma unroll
      for (int r = 0; r < 16; ++r) { pA0[r] = __builtin_amdgcn_exp2f(pA0[r]); pA1[r] = __builtin_amdgcn_exp2f(pA1[r]); } }
    WAIT_BAR(0);
    DMA_K(3, 3); DMA_V(1, 1);
    ROT();
#pragma unroll
    for (int j = 0; j < 4; ++j) { kf[2 * j] = KF(kp0 + ks * KSLOT + j * 2048); kf[2 * j + 1] = KF(kp0 + ks * KSLOT + j * 2048 + 512); }
    WAIT_BAR(3);
    s16x4 vlo[8], vhi[8]; v4u pw0, pw1, pw2, pw3;
#define PAF(k) __builtin_bit_cast(bf16x8, pw##k)
#define VFR(i) (bf16x8){vlo[i][0], vlo[i][1], vlo[i][2], vlo[i][3], vhi[i][0], vhi[i][1], vhi[i][2], vhi[i][3]}
#define GAPA(MF, X, B, PW, H) do { MF; sacc0 += X[B]; sacc1 += X[B + 1]; sacc0 += X[B + 2]; sacc1 += X[B + 3]; PIN(sacc0); PIN(sacc1); \
        PW[2 * (H)] = cvtpk(X[B], X[B + 1]); PW[2 * (H) + 1] = cvtpk(X[B + 2], X[B + 3]); PIN(PW); SBAR(); } while (0)
#define EX(v) __builtin_amdgcn_exp2f(v)
#define VRD(i) do { vlo[i] = vtr(vp_ + (((i) >> 2) * 4096 + ((i) & 3) * 1024)); vhi[i] = vtr(vp_ + (((i) >> 2) * 4096 + ((i) & 3) * 1024 + 512)); } while (0)
#define KRD(G, j) do { if (G) { kf[2 * (j)] = KF(kp0 + ((ks + 1) & 3) * KSLOT + (j) * 2048); kf[2 * (j) + 1] = KF(kp0 + ((ks + 1) & 3) * KSLOT + (j) * 2048 + 512); } } while (0)
#define KR2(j) do { kf[2 * (j)] = KF(kp0 + ks * KSLOT + (j) * 2048); kf[2 * (j) + 1] = KF(kp0 + ks * KSLOT + (j) * 2048 + 512); } while (0)
#define GAPB(PRE, MF, X, B) do { PRE; SBAR(); MF; X[B] = EX(X[B]); X[B + 1] = EX(X[B + 1]); X[B + 2] = EX(X[B + 2]); X[B + 3] = EX(X[B + 3]); PIN(X); SBAR(); } while (0)
#define STEP(C0, C1, P0, P1, t, GK, GV, GL, PEEL) do { SBAR(); \
        const LAS unsigned char* vp_ = vp0 + sl_prev * VSLOT; \
        if (PEEL) { if ((t) - 1 > cw) { _Pragma("unroll") for (int r = 0; r < 16; ++r) { P0[r] = 0.f; P1[r] = 0.f; } } } \
        float sacc0 = 0.f, sacc1 = 0.f; \
        VRD(0); SBAR(); GAPA(C0 = MFMA(kf[0], qr[0], zc), P0, 0, pw0, 0); \
        VRD(4); SBAR(); GAPA(C1 = MFMA(kf[1], qr[0], zc), P0, 4, pw0, 1); \
        VRD(1); SBAR(); GAPA(C0 = MFMA(kf[2], qr[1], C0), P0, 8, pw1, 0); \
        VRD(5); SBAR(); GAPA(C1 = MFMA(kf[3], qr[1], C1), P0, 12, pw1, 1); \
        KR2(4); SBAR(); GAPA(C0 = MFMA(kf[4], qr[2], C0), P1, 0, pw2, 0); \
        KR2(5); SBAR(); GAPA(C1 = MFMA(kf[5], qr[2], C1), P1, 4, pw2, 1); \
        GAPA(C0 = MFMA(kf[6], qr[3], C0), P1, 8, pw3, 0); \
        GAPA(C1 = MFMA(kf[7], qr[3], C1), P1, 12, pw3, 1); \
        l_reg += sacc0 + sacc1; \
        VRD(2); SBAR(); C0 = MFMA(kf[8], qr[4], C0); SBAR(); \
        VRD(6); SBAR(); C1 = MFMA(kf[9], qr[4], C1); SBAR(); \
        VRD(3); SBAR(); C0 = MFMA(kf[10], qr[5], C0); SBAR(); \
        VRD(7); SBAR(); C1 = MFMA(kf[11], qr[5], C1); SBAR(); \
        if (GK) { DMA_K((t) + 3, (ks + 3) & 3); } if (GV) { DMA_V((t) + 1, sl_next); } \
        SBAR(); \
        GAPB((void)0, o[0] = MFMA(PAF(0), VFR(0), o[0]), C0, 0); \
        GAPB(KRD(GL, 0), o[1] = MFMA(PAF(0), VFR(4), o[1]), C0, 4); \
        GAPB(KRD(GL, 1), o[0] = MFMA(PAF(1), VFR(1), o[0]), C0, 8); \
        GAPB(KRD(GL, 2), o[1] = MFMA(PAF(1), VFR(5), o[1]), C0, 12); \
        GAPB(KRD(GL, 3), o[0] = MFMA(PAF(2), VFR(2), o[0]), C1, 0); \
        GAPB((void)0, o[1] = MFMA(PAF(2), VFR(6), o[1]), C1, 4); \
        GAPB((void)0, o[0] = MFMA(PAF(3), VFR(3), o[0]), C1, 8); \
        GAPB((void)0, o[1] = MFMA(PAF(3), VFR(7), o[1]), C1, 12); \
    } while (0)
    int t = 1;
    for (; t + 5 < NT; t += 2) {
        STEP(pB0, pB1, pA0, pA1, t, true, true, true, false);     WAIT_BAR(3); ROT();
        STEP(pA0, pA1, pB0, pB1, t + 1, true, true, true, false); WAIT_BAR(3); ROT();
    }
#define ENDW(tt) do { if ((tt) + 3 < NT) { WAIT_BAR(3); } else if ((tt) + 2 < NT) { WAIT_BAR(1); } else { WAIT_BAR(0); } } while (0)
    for (; t + 1 < NT; t += 2) {
        STEP(pB0, pB1, pA0, pA1, t, (t + 3 < NT), (t + 1 < NT), (t + 1 < NT), true);     ENDW(t);     ROT();
        STEP(pA0, pA1, pB0, pB1, t + 1, (t + 4 < NT), (t + 2 < NT), (t + 2 < NT), true); ENDW(t + 1); ROT();
    }
    STEP(pB0, pB1, pA0, pA1, NT - 1, false, false, false, true);
    { if (NT - 1 > cw) {
#pragma unroll
          for (int r = 0; r < 16; ++r) { pB0[r] = 0.f; pB1[r] = 0.f; } }
      float sacc = 0.f;
#pragma unroll
      for (int r = 0; r < 16; ++r) sacc += pB0[r] + pB1[r];
      l_reg += sacc;
      pw0 = (v4u){cvtpk(pB0[0], pB0[1]), cvtpk(pB0[2], pB0[3]), cvtpk(pB0[4], pB0[5]), cvtpk(pB0[6], pB0[7])};
      pw1 = (v4u){cvtpk(pB0[8], pB0[9]), cvtpk(pB0[10], pB0[11]), cvtpk(pB0[12], pB0[13]), cvtpk(pB0[14], pB0[15])};
      pw2 = (v4u){cvtpk(pB1[0], pB1[1]), cvtpk(pB1[2], pB1[3]), cvtpk(pB1[4], pB1[5]), cvtpk(pB1[6], pB1[7])};
      pw3 = (v4u){cvtpk(pB1[8], pB1[9]), cvtpk(pB1[10], pB1[11]), cvtpk(pB1[12], pB1[13]), cvtpk(pB1[14], pB1[15])};
      const LAS unsigned char* vp_ = vp0 + sl_cur * VSLOT;
      s16x4 dlo[8], dhi[8];
#pragma unroll
      for (int f = 0; f < 8; ++f) { dlo[f] = vtr(vp_ + ((f >> 2) * 4096 + (f & 3) * 1024)); dhi[f] = vtr(vp_ + ((f >> 2) * 4096 + (f & 3) * 1024 + 512)); }
#define DFR(f) (bf16x8){dlo[f][0], dlo[f][1], dlo[f][2], dlo[f][3], dhi[f][0], dhi[f][1], dhi[f][2], dhi[f][3]}
      o[0] = MFMA(PAF(0), DFR(0), o[0]); o[1] = MFMA(PAF(0), DFR(4), o[1]); o[0] = MFMA(PAF(1), DFR(1), o[0]); o[1] = MFMA(PAF(1), DFR(5), o[1]);
      o[0] = MFMA(PAF(2), DFR(2), o[0]); o[1] = MFMA(PAF(2), DFR(6), o[1]); o[0] = MFMA(PAF(3), DFR(3), o[0]); o[1] = MFMA(PAF(3), DFR(7), o[1]);
#undef DFR
    }
    { const unsigned lu = __float_as_uint(l_reg); auto rr = __builtin_amdgcn_permlane32_swap(lu, lu, false, false); l_reg = __uint_as_float(rr[0]) + __uint_as_float(rr[1]); }
    if (hi == 0) wsf[32 + r32] = l_reg;
    asm volatile("s_waitcnt lgkmcnt(0)" : : : "memory");
    float rli[16];
#pragma unroll
    for (int r = 0; r < 16; ++r) rli[r] = __builtin_amdgcn_rcpf(wsf[32 + (r & 3) + 8 * (r >> 2) + 4 * hi]);
    bf16_t* Ow = O + (rowbase + q0 + wid * 32) * 1024 + h * 64;
    { LAS bf16_t* stg = (LAS bf16_t*)(lds + L_OST) + wid * 2048;
#pragma unroll
      for (int r = 0; r < 16; ++r) { const int orow = (r & 3) + 8 * (r >> 2) + 4 * hi;
#pragma unroll
          for (int d0 = 0; d0 < 2; ++d0) stg[orow * 64 + d0 * 32 + r32] = (bf16_t)cvtpk(o[d0][r] * rli[r], 0.f); }
      asm volatile("s_waitcnt lgkmcnt(0)" : : : "memory");
#pragma unroll
      for (int i = 0; i < 4; ++i) { const int row = i * 8 + (lane >> 3), ch = lane & 7; const v4u v = *(const LAS v4u*)(stg + row * 64 + ch * 8); *(v4u*)(Ow + (size_t)row * 1024 + ch * 8) = v; } }
    asm volatile("s_waitcnt lgkmcnt(0)\n\ts_barrier" : : : "memory");
#undef RFL
#undef DMA_K
#undef DMA_V
#undef SBAR
#undef PIN
#undef WAIT_BAR
#undef ROT
#undef KF
#undef MFMA
#undef PAF
#undef VFR
#undef GAPA
#undef EX
#undef VRD
#undef KRD
#undef GAPB
#undef STEP
#undef ENDW
}
__device__ __forceinline__ bool b_fast(const float* gq, const float* gk, int lane) {
    float a = fabsf(gq[lane]), c2 = fabsf(gk[lane]); if (lane < 32) { a = fmaxf(a, fabsf(gq[64 + lane])); c2 = fmaxf(c2, fabsf(gk[64 + lane])); }
#pragma unroll
    for (int o_ = 1; o_ < 64; o_ <<= 1) { a = fmaxf(a, __shfl_xor(a, o_)); c2 = fmaxf(c2, __shfl_xor(c2, o_)); }
    return 9.7979589711f * a * c2 * LOG2E * 1.02f < 100.0f;
}
__device__ __forceinline__ bool a_fast(const float* bias, const float* gq, const float* gk, int lane) {
    float a = fabsf(gq[lane]), c2 = fabsf(gk[lane]), mb = 0.f;
#pragma unroll
    for (int i = 0; i < 8; ++i) mb = fmaxf(mb, fabsf(bias[lane + 64 * i]));
#pragma unroll
    for (int o_ = 1; o_ < 64; o_ <<= 1) { a = fmaxf(a, __shfl_xor(a, o_)); c2 = fmaxf(c2, __shfl_xor(c2, o_)); mb = fmaxf(mb, __shfl_xor(mb, o_)); }
    return 8.0f * a * c2 * LOG2E * 1.02f + 2.0f * mb * LOG2E < 100.0f;
}
template <int DQK, int MODE, class Pre>
__device__ __forceinline__ void attn_phase(LAS unsigned char* lds, const bf16_t* Q, const bf16_t* K, const bf16_t* V, bf16_t* O, const unsigned* MASK, const float* bias, const float* gq, const float* gk, int vcu, int G_, const Pre& pre) {
    bool fast = false;
    if (MODE == 0) fast = a_fast(bias, gq, gk, (int)(threadIdx.x & 63)); else if (MODE == 1) fast = b_fast(gq, gk, (int)(threadIdx.x & 63));
    for (int u = vcu; u < 1024; u += G_) {
        const int g = u & 255, k = u >> 8;
        pre(k);
        const int p = g & 15, bh = 2 * (g >> 4) + (k >> 1), qt = (k & 1) ? (31 - p) : p;
        if (MODE == 0 && fast) attn_unit_a(lds, Q, K, V, O, MASK, bias, gq, gk, bh >> 4, bh & 15, qt, (k & 1) == 0);
        else if (MODE == 1 && fast) attn_unit_b(lds, Q, K, V, O, gq, bias, bh >> 4, bh & 15, qt);
        else attn_unit<DQK, MODE>(lds, Q, K, V, O, MASK, bias, gq, gk, bh >> 4, bh & 15, qt);
    }
}
}
namespace idx {
typedef short bf16x8 __attribute__((ext_vector_type(8)));
typedef float f32x16 __attribute__((ext_vector_type(16)));
typedef int v4i __attribute__((ext_vector_type(4)));
constexpr int LCAP = 512;
constexpr int OFF_DUMMY = 65536, OFF_RES = 65536 + 256, OFF_CNT = OFF_RES + 64, OFF_RED = OFF_RES + 128, OFF_LIST = 65536 + 1024, OFF_QF = OFF_LIST + 4 * LCAP * 8;
__device__ __forceinline__ float relu(float x) { return __builtin_amdgcn_fmed3f(x, 0.0f, __builtin_inff()); }

__device__ __forceinline__ int wave_prefix_incl(int v) {
    v += __builtin_amdgcn_update_dpp(0, v, 0x111, 0xf, 0xf, false);
    v += __builtin_amdgcn_update_dpp(0, v, 0x112, 0xf, 0xf, false);
    v += __builtin_amdgcn_update_dpp(0, v, 0x114, 0xf, 0xf, false);
    v += __builtin_amdgcn_update_dpp(0, v, 0x118, 0xf, 0xf, false);
    v += __builtin_amdgcn_update_dpp(0, v, 0x142, 0xa, 0xf, false);
    v += __builtin_amdgcn_update_dpp(0, v, 0x143, 0xc, 0xf, false);
    return v;
}
__device__ __forceinline__ void idx_unit(LAS unsigned char* lds, const bf16_t* __restrict__ QI, const bf16_t* __restrict__ KI, const float* __restrict__ WI, unsigned* __restrict__ MASK, int b, int c, int sub, int par, bool has_next, int nb, int nc, int nsub) {
    int tid_ = threadIdx.x; asm volatile("" : "+v"(tid_));
    const int tid = tid_, lane = tid & 63, hi = lane >> 5, n = lane & 31; const int wid = __builtin_amdgcn_readfirstlane(tid >> 6);
    const size_t rowbase = (size_t)b * SEQ; const int row0 = c * 64 + 4 * sub;
    const int ntiles = 2 * (c + 1);
#define IDX_STAGE_NEXT(t_) do { const int r_ = (t_) >> 3, pc_ = (t_) & 7; \
        *(LAS v4u*)(lds + OFF_QF + (par ^ 1) * 4608 + r_ * 144 + pc_ * 16) = *(const v4u*)(QI + ((size_t)nb * SEQ + nc * 64 + 4 * nsub + (r_ >> 3)) * 512 + (r_ & 7) * 64 + pc_ * 8); } while (0)
    unsigned* mrow0 = MASK + (rowbase + row0 + 2 * hi) * 256;
    if (ntiles <= 8) {
        if (n == 0) { for (int T = wid; T < ntiles; T += 8) { mrow0[T] = 0xffffffffu; mrow0[256 + T] = 0xffffffffu; } }
        if (has_next) { if (tid < 256) IDX_STAGE_NEXT(tid); __syncthreads(); }
        return;
    }
    const unsigned dummy = (unsigned)OFF_DUMMY + 4u * (unsigned)lane;
    const unsigned qb0 = (unsigned)(2 * hi) * 16384u, qb1 = qb0 + 16384u;
    const LAS unsigned char* qfp = lds + OFF_QF + par * 4608 + n * 144 + hi * 16;
    float wr[16];
#pragma unroll
    for (int i = 0; i < 16; ++i) wr[i] = WI[(rowbase + row0 + (i >> 2)) * 8 + (i & 3) + 4 * hi] * (0.125f * 0.35355339059327373f);
    const bf16_t* kp = KI + rowbase * 64 + 8 * lane;
    const int np = (ntiles + 15) >> 4;
    const int rot = (5 * sub + 3 * b + c) % np;
    unsigned key[32][2];
    bf16x8 kf[2][2][4];
#define IDX_PR(kk) ((kk) + rot - (((kk) + rot >= np) ? np : 0))
#define IDX_LOAD(buf, kk) do { const int pr_ = IDX_PR(kk); _Pragma("unroll") for (int u_ = 0; u_ < 2; ++u_) { int T_ = 8 * (2 * pr_ + u_) + wid; T_ = T_ < ntiles ? T_ : ntiles - 1; const bf16_t* kt_ = kp + (size_t)T_ * 2048; \
        _Pragma("unroll") for (int s_ = 0; s_ < 4; ++s_) kf[buf][u_][s_] = *(const bf16x8*)(kt_ + 512 * s_); } } while (0)
    IDX_LOAD(0, 0);
#pragma unroll
    for (int kk = 0; kk < 16; ++kk) {
        key[2 * kk][0] = 0u; key[2 * kk][1] = 0u; key[2 * kk + 1][0] = 0u; key[2 * kk + 1][1] = 0u;
        if (kk < np) {
            const int pr = IDX_PR(kk);
            f32x16 acc[2];
#pragma unroll
            for (int i = 0; i < 16; ++i) { acc[0][i] = 0.f; acc[1][i] = 0.f; }
            if (kk + 1 < 16) { if (kk + 1 < np) IDX_LOAD((kk + 1) & 1, kk + 1); }
#pragma unroll
            for (int s = 0; s < 4; ++s) { const bf16x8 qf = *(const LAS bf16x8*)(qfp + 32 * s);
                                          acc[0] = __builtin_amdgcn_mfma_f32_32x32x16_bf16(qf, kf[kk & 1][0][s], acc[0], 0, 0, 0);
                                          acc[1] = __builtin_amdgcn_mfma_f32_32x32x16_bf16(qf, kf[kk & 1][1][s], acc[1], 0, 0, 0); }
#pragma unroll
            for (int u = 0; u < 2; ++u) {
                const bool valid = 8 * (2 * pr + u) + wid < ntiles;
                float p[4];
#pragma unroll
                for (int q = 0; q < 4; ++q) { float a = relu(acc[u][4 * q]) * wr[4 * q];
#pragma unroll
                    for (int j = 1; j < 4; ++j) a += relu(acc[u][4 * q + j]) * wr[4 * q + j];
                    p[q] = a; }
#pragma unroll
                for (int e = 0; e < 2; ++e) {
                    const auto rr = __builtin_amdgcn_permlane32_swap(__float_as_uint(p[e]), __float_as_uint(p[2 + e]), false, false);
                    const unsigned kv = valid ? fkey(__uint_as_float(rr[0]) + __uint_as_float(rr[1]) + 0.0f) : 0u;
                    key[2 * kk + u][e] = kv;
                    __hip_atomic_fetch_add((LAS unsigned*)(lds + (valid ? ((e ? qb1 : qb0) + 4u * (kv >> 20)) : dummy)), 1u, __ATOMIC_RELAXED, __HIP_MEMORY_SCOPE_WORKGROUP);
                }
            }
        }
    }
#undef IDX_LOAD
    LAS unsigned* H = (LAS unsigned*)lds;
    volatile LAS int* res = (volatile LAS int*)(lds + OFF_RES);
    LAS unsigned* lcnt = (LAS unsigned*)(lds + OFF_CNT);
    __syncthreads();
    if (wid < 4) {
        const int q = wid; const LAS unsigned* Hq = H + q * 4096; const int grp = 63 - lane;
        unsigned sg = 0u;
#pragma unroll 4
        for (int i = 0; i < 16; ++i) { const v4u t = *(const LAS v4u*)(Hq + 64 * grp + 4 * ((i + lane) & 15)); sg += (t.x + t.y) + (t.z + t.w); }
        const int pre = wave_prefix_incl((int)sg);
        const int need = 256;
        const int l1 = 64 - __popcll(__ballot(pre >= need));
        const int js = 63 - l1;
        const int above_c = __builtin_amdgcn_readlane(pre - (int)sg, l1);
        const unsigned f = Hq[64 * js + 63 - lane];
        const int pre2 = wave_prefix_incl((int)f);
        const int l2 = 64 - __popcll(__ballot(above_c + pre2 >= need));
        const int ls = 63 - l2;
        const int above = above_c + __builtin_amdgcn_readlane(pre2 - (int)f, l2);
        const int cnt = __builtin_amdgcn_readlane((int)f, l2);
        if (lane == 0) { res[q * 4 + 0] = (64 * js + ls) << 20; res[q * 4 + 1] = need - above; res[q * 4 + 2] = cnt; }
    }
    __syncthreads();
    const unsigned d0 = (unsigned)res[(2 * hi) * 4] >> 20, d1 = (unsigned)res[(2 * hi + 1) * 4] >> 20;
    const bool overflow = res[2] > LCAP || res[6] > LCAP || res[10] > LCAP || res[14] > LCAP;
    unsigned Tq0, Tq1; int J0, J1;
    if (!overflow) {
        LAS v2u* list = (LAS v2u*)(lds + OFF_LIST);
#pragma unroll
        for (int k = 0; k < 32; ++k) {
            const int pr = IDX_PR(k >> 1); const unsigned kidx = 32u * (unsigned)(8 * (2 * pr + (k & 1)) + wid) + (unsigned)n;
#pragma unroll
            for (int e = 0; e < 2; ++e) { const unsigned kv = key[k][e];
                if ((kv >> 20) == (e ? d1 : d0)) { const unsigned pos = __hip_atomic_fetch_add(lcnt + 2 * hi + e, 1u, __ATOMIC_RELAXED, __HIP_MEMORY_SCOPE_WORKGROUP);
                    if (pos < (unsigned)LCAP) list[(2 * hi + e) * LCAP + pos] = (v2u){kv, kidx}; } }
        }
        __syncthreads();
        if (wid < 4) {
            const int q = wid; const int L = res[q * 4 + 2], need = res[q * 4 + 1];
            unsigned ck[LCAP / 64], ci[LCAP / 64];
#pragma unroll
            for (int i = 0; i < LCAP / 64; ++i) { ck[i] = 0u; ci[i] = 0xffffffffu; if (i * 64 < L) { if (i * 64 + lane < L) { const v2u t = list[q * LCAP + i * 64 + lane]; ck[i] = t.x; ci[i] = t.y; } } }
            unsigned T = (unsigned)res[q * 4 + 0];
            if (L <= 64) {
                const unsigned k0 = ck[0];
                for (int sh = 16; sh >= 0; sh -= 4) { int dsel = 0;
#pragma unroll
                    for (int d = 1; d < 16; ++d) dsel += (__popcll(__ballot(k0 >= (T | ((unsigned)d << sh)))) >= need) ? 1 : 0;
                    T |= (unsigned)dsel << sh; }
            } else
            for (int bit = 19; bit >= 0; --bit) {
                const unsigned cand = T | (1u << bit); int cnt = 0;
#pragma unroll
                for (int i = 0; i < LCAP / 64; ++i) if (i * 64 < L) cnt += __popcll(__ballot(ck[i] >= cand));
                if (cnt >= need) T = cand;
            }
            int cgt = 0, ceq = 0;
#pragma unroll
            for (int i = 0; i < LCAP / 64; ++i) if (i * 64 < L) { cgt += __popcll(__ballot(ck[i] > T)); ceq += __popcll(__ballot(ck[i] == T)); }
            const int neq = need - cgt;
            int J = SEQ;
            if (neq < ceq) { int Jb = 0;
                for (int bit = 13; bit >= 0; --bit) { const unsigned cj = (unsigned)(Jb | (1 << bit)); int cnt = 0;
#pragma unroll
                    for (int i = 0; i < LCAP / 64; ++i) if (i * 64 < L) cnt += __popcll(__ballot(ck[i] == T && ci[i] < cj));
                    if (cnt < neq) Jb = (int)cj; }
                J = Jb + 1; }
            if (lane == 0) { res[q * 4 + 0] = (int)T; res[q * 4 + 1] = J; }
        } else {
            v4u qn_ = {0u, 0u, 0u, 0u}; const int t_ = tid - 256, r_ = t_ >> 3, pc_ = t_ & 7;
            if (has_next) qn_ = *(const v4u*)(QI + ((size_t)nb * SEQ + nc * 64 + 4 * nsub + (r_ >> 3)) * 512 + (r_ & 7) * 64 + pc_ * 8);
            for (int i = tid - 256; i < 4096; i += 256) ((LAS v4u*)lds)[i] = (v4u){0u, 0u, 0u, 0u};
            if (has_next) *(LAS v4u*)(lds + OFF_QF + (par ^ 1) * 4608 + r_ * 144 + pc_ * 16) = qn_;
        }
        __syncthreads();
        Tq0 = (unsigned)res[(2 * hi) * 4]; Tq1 = (unsigned)res[(2 * hi + 1) * 4]; J0 = res[(2 * hi) * 4 + 1]; J1 = res[(2 * hi + 1) * 4 + 1];
    } else {
        unsigned pre0 = d0 << 20, pre1 = d1 << 20;
#pragma unroll
        for (int pass = 1; pass < 3; ++pass) {
            const int sh = pass == 1 ? 8 : 0; const unsigned dm = pass == 1 ? 0xfffu : 0xffu;
            __syncthreads();
            for (int i = tid; i < 4096; i += NTHR) ((LAS v4u*)lds)[i] = (v4u){0u, 0u, 0u, 0u};
            __syncthreads();
#pragma unroll
            for (int k = 0; k < 32; ++k)
#pragma unroll
                for (int e = 0; e < 2; ++e) { const unsigned kv = key[k][e], pre = e ? pre1 : pre0;
                    const bool ok = pass == 1 ? ((kv >> 20) == (pre >> 20)) : ((kv >> 8) == (pre >> 8));
                    const unsigned addr = ok ? ((e ? qb1 : qb0) + 4u * ((kv >> sh) & dm)) : dummy;
                    __hip_atomic_fetch_add((LAS unsigned*)(lds + addr), 1u, __ATOMIC_RELAXED, __HIP_MEMORY_SCOPE_WORKGROUP); }
            __syncthreads();
            if (wid < 4) {
                const int q = wid; const LAS unsigned* Hq = H + q * 4096;
                unsigned sg = 0u;
#pragma unroll
                for (int i = 0; i < 16; ++i) { const v4u t = *(const LAS v4u*)(Hq + 64 * lane + 4 * i); sg += (t.x + t.y) + (t.z + t.w); }
                int suf = (int)sg;
#pragma unroll
                for (int o = 1; o < 64; o <<= 1) { const int t = __shfl_down(suf, o); if (lane + o < 64) suf += t; }
                const int need = res[q * 4 + 1];
                const int js = __popcll(__ballot(suf >= need)) - 1;
                const int above_c = __shfl(suf - (int)sg, js);
                const unsigned f = Hq[64 * js + lane];
                int suf2 = (int)f;
#pragma unroll
                for (int o = 1; o < 64; o <<= 1) { const int t = __shfl_down(suf2, o); if (lane + o < 64) suf2 += t; }
                const int ls = __popcll(__ballot(above_c + suf2 >= need)) - 1;
                const int above = above_c + __shfl(suf2 - (int)f, ls);
                const int cnt = __shfl((int)f, ls);
                if (lane == 0) { res[q * 4 + 0] = res[q * 4 + 0] | ((64 * js + ls) << sh); res[q * 4 + 1] = need - above; res[q * 4 + 2] = cnt; }
            }
            __syncthreads();
            pre0 = (unsigned)res[(2 * hi) * 4]; pre1 = (unsigned)res[(2 * hi + 1) * 4];
        }
        Tq0 = pre0; Tq1 = pre1;
        volatile LAS v4i* red = (volatile LAS v4i*)(lds + OFF_RED);
        const int needa = res[(2 * hi) * 4 + 1], needb = res[(2 * hi + 1) * 4 + 1];
        int Jb0 = 0, Jb1 = 0;
        for (int bit = 13; bit >= 0; --bit) {
            const int cj0 = Jb0 | (1 << bit), cj1 = Jb1 | (1 << bit);
            int n0 = 0, n1 = 0, n2 = 0, n3 = 0;
#pragma unroll
            for (int k = 0; k < 32; ++k) { const int pr = IDX_PR(k >> 1); const int kidx = 32 * (8 * (2 * pr + (k & 1)) + wid) + n;
                const unsigned long long m0 = __ballot(key[k][0] == Tq0 && kidx < cj0), m1 = __ballot(key[k][1] == Tq1 && kidx < cj1);
                n0 += __popc((unsigned)m0); n2 += __popc((unsigned)(m0 >> 32)); n1 += __popc((unsigned)m1); n3 += __popc((unsigned)(m1 >> 32)); }
            __syncthreads();
            if (lane == 0) red[wid] = (v4i){n0, n1, n2, n3};
            __syncthreads();
            v4i tot = red[0];
#pragma unroll
            for (int w = 1; w < 8; ++w) { const v4i t = red[w]; tot += t; }
            if ((hi ? tot[2] : tot[0]) < needa) Jb0 = cj0;
            if ((hi ? tot[3] : tot[1]) < needb) Jb1 = cj1;
        }
        J0 = Jb0 + 1; J1 = Jb1 + 1;
        for (int i = tid; i < 4096; i += NTHR) ((LAS v4u*)lds)[i] = (v4u){0u, 0u, 0u, 0u};
        if (has_next && tid < 256) IDX_STAGE_NEXT(tid);
        __syncthreads();
    }
    if (tid < 4) ((LAS unsigned*)(lds + OFF_CNT))[tid] = 0u;
    const bool notie = __all(J0 == SEQ && J1 == SEQ) != 0;
    unsigned w0 = 0u, w1 = 0u;
#define IDX_WL(w, val, ln) asm("v_writelane_b32 %0, %1, %2" : "+v"(w) : "s"(val), "n"(ln))
#pragma unroll
    for (int k = 0; k < 32; ++k) {
        const int pr = IDX_PR(k >> 1); const int T = 8 * (2 * pr + (k & 1)) + wid;
        if ((k >> 1) < np && T < ntiles) {
            const int kidx = 32 * T + n;
            unsigned long long m0, m1;
            if (notie) { m0 = __ballot(key[k][0] >= Tq0); m1 = __ballot(key[k][1] >= Tq1); }
            else { m0 = __ballot(key[k][0] > Tq0 || (key[k][0] == Tq0 && kidx < J0)); m1 = __ballot(key[k][1] > Tq1 || (key[k][1] == Tq1 && kidx < J1)); }
            IDX_WL(w0, (unsigned)m0, k); IDX_WL(w0, (unsigned)(m0 >> 32), 32 + k); IDX_WL(w1, (unsigned)m1, k); IDX_WL(w1, (unsigned)(m1 >> 32), 32 + k);
            __builtin_amdgcn_sched_barrier(0);
        }
    }
    { const int kk = n >> 1, pr = IDX_PR(kk), T = 8 * (2 * pr + (n & 1)) + wid;
      if (kk < np && T < ntiles) { mrow0[T] = w0; mrow0[256 + T] = w1; } }
#undef IDX_WL
#undef IDX_PR
#undef IDX_STAGE_NEXT
}
__device__ __forceinline__ void idx_phase(LAS unsigned char* lds, const bf16_t* QI, const bf16_t* KI, const float* WI, unsigned* MASK, int vcu, int G_) {
    const int g = vcu & 255;
    for (int i = threadIdx.x; i < 4096; i += NTHR) ((LAS v4u*)lds)[i] = (v4u){0u, 0u, 0u, 0u};
    if (threadIdx.x < 4) ((LAS unsigned*)(lds + OFF_CNT))[threadIdx.x] = 0u;
    if (vcu < 4096 && threadIdx.x < 256) { const int r0_ = g; const int b0_ = (r0_ >> 4) & 1, c0_ = 127 - (r0_ >> 5), s0_ = r0_ & 15; const int r_ = threadIdx.x >> 3, pc_ = threadIdx.x & 7;
        *(LAS v4u*)(lds + OFF_QF + r_ * 144 + pc_ * 16) = *(const v4u*)(QI + ((size_t)b0_ * SEQ + c0_ * 64 + 4 * s0_ + (r_ >> 3)) * 512 + (r_ & 7) * 64 + pc_ * 8); }
    __syncthreads();
    for (int u = vcu; u < 4096; u += G_) {
        const int k = u >> 8;
        const int pos = (k & 1) ? (255 - g) : g, r = 256 * k + pos;
        const bool has_next = u + G_ < 4096; const int k1 = k + 1, pos1 = (k1 & 1) ? (255 - g) : g, r1 = 256 * k1 + pos1;
        idx_unit(lds, QI, KI, WI, MASK, (r >> 4) & 1, 127 - (r >> 5), r & 15, k & 1, has_next, (r1 >> 4) & 1, 127 - (r1 >> 5), r1 & 15);
    }
}
}
constexpr size_t MiB = 1u << 20;
constexpr size_t WS_CTL = 0, CTL_ZERO_BYTES = 1 * MiB;
constexpr size_t WS_ROPE = 1 * MiB;
constexpr size_t WS_SSQ = 2 * MiB;
constexpr size_t WS_W = 10 * MiB;
constexpr size_t W_IN = 0, W_OUT = 15 * MiB / 2, W_UP = 19 * MiB / 2, W_DN = 41 * MiB / 2, W_UQ = 26 * MiB, W_UKV = 26 * MiB + 3 * MiB / 4;
constexpr size_t WS_H = 38 * MiB;
constexpr size_t WS_BIG = 70 * MiB;
constexpr size_t WS_END = WS_BIG + 272 * MiB;
constexpr size_t B_SCRB = 0, B_Q = 120 * MiB, B_K = 152 * MiB, B_V = 184 * MiB, B_QI = 216 * MiB, B_KI = 232 * MiB, B_WI = 234 * MiB, B_MASK = 235 * MiB, B_O = 0;
constexpr size_t BB_CQN = 16 * MiB, BB_CKVN = 24 * MiB, BB_KR = 28 * MiB, BB_SCRQ = 32 * MiB, BB_SCRKV = 80 * MiB, BB_QB = 144 * MiB, BB_KB = 192 * MiB, BB_VB = 240 * MiB, BB_O = 144 * MiB;
constexpr size_t B_U = 0, B_ACT = 176 * MiB;
constexpr int CW_BAR = 4096;
constexpr int MAX_LAUNCH = 16;
static_assert((CW_BAR + MAX_LAUNCH * XCD_BAR_WORDS) * 4 <= (int)CTL_ZERO_BYTES, "barrier regions inside the memset region");
constexpr int RING_BYTES = 131072, LDSCTL_OFF = RING_BYTES, MISC_OFF = LDSCTL_OFF + 320, LDS_BYTES = 147456;
constexpr int NPH = 13;

struct Args { const float* in[26]; float* out; unsigned char* ws; int ph_lo, ph_hi, li, pad, rep, pad2; };

struct Ctx { LAS unsigned char* lds; const Args* a; unsigned char* ws; int lo, hi, lane, wave, vcu, G, gw, NGW; bool first; };

template <int L>
__device__ __forceinline__ void prep_mixer(const Args& args, unsigned char* wreg, LAS float* scr, int iw, int NIW, int lane) {
    constexpr int kind = L % 3, jj = L / 3;
    const float* gmix = args.in[1] + (size_t)L * D_MODEL;
#define CONV(src, dst, K_, N_, Np_, g_, hc_) do { const int nblk_ = (Np_) / 32, nit_ = ((K_) / 64) * nblk_; for (int it = iw; it < nit_; it += NIW) tr_item((src), (K_), (N_), (bf16_t*)(dst), scr, it, nblk_, lane, (g_), (hc_)); } while (0)
    if (kind == 0) { CONV(args.in[4] + (size_t)jj * D_MODEL * A_IN, wreg + W_IN, 1024, A_IN, A_INP, gmix, 2048); CONV(args.in[8] + (size_t)jj * 1024 * 1024, wreg + W_OUT, 1024, 1024, 1024, nullptr, 0); }
    else if (kind == 1) { CONV(args.in[9], wreg + W_IN, 1024, B_DOWN, B_DOWNP, gmix, 0); CONV(args.in[12], wreg + W_UQ, 256, 1536, 1536, nullptr, 0); CONV(args.in[13], wreg + W_UKV, 128, 2048, 2048, nullptr, 0); CONV(args.in[16], wreg + W_OUT, 1024, 1024, 1024, nullptr, 0); }
    else { CONV(args.in[17], wreg + W_IN, 1024, 3072, 3072, gmix, 2048); CONV(args.in[21], wreg + W_OUT, 1024, 1024, 1024, nullptr, 0); }
#undef CONV
}
#define SEAM() do { if (!c.first) xcd_barrier(bar); c.first = false; } while (0)
template <int LAYER>
__device__ __forceinline__ void run_layer(Ctx& c, const XcdBarrier& bar) {
    constexpr int kind = LAYER % 3, jj = LAYER / 3;
    const Args& args = *c.a;
    LAS unsigned char* lds = c.lds;
    const int lane = c.lane, gw = c.gw, NGW = c.NGW, G_ = c.G, vcu = c.vcu;
    float* X = args.out;
    const float* xsrc = LAYER == 0 ? args.in[0] : X;
    unsigned char* ws = c.ws;
    float* ROPE = (float*)(ws + WS_ROPE);
    bf16_t* Hb = (bf16_t*)(ws + WS_H);
    float* SSQ = (float*)(ws + WS_SSQ) + (size_t)(2 * LAYER) * M_TOK * 16;
    unsigned char* big = ws + WS_BIG; unsigned char* wreg = ws + WS_W;
#define RUN(k) (c.lo <= LAYER * NPH + (k) && LAYER * NPH + (k) < c.hi)
    if (LAYER == 0 && RUN(0)) { SEAM();
      {
        LAS float* scr = (LAS float*)(lds + c.wave * 16384);
        prep_mixer<0>(args, wreg, scr, gw, NGW, lane);
        for (int m = gw; m < M_TOK; m += 4 * NGW) xb_rows4(xsrc, Hb, SSQ, m, NGW, lane);
        rope_fill(ROPE, gw, NGW, lane);
      }
    }
    if (RUN(1)) { SEAM();
      {
        constexpr int N = kind == 0 ? A_INP : (kind == 1 ? B_DOWNP : 3072);
        pg8::Gemm g{Hb, (const bf16_t*)(wreg + W_IN), M_TOK, N, 1024}; pg8::StaticOrder S; S.init(M_TOK, N, G_, (int)blockIdx.x);
        if constexpr (kind == 1) { pg8::EpiStore E{(bf16_t*)(big + B_SCRB), N, SSQ}; pg8::gemm_phase<pg8::EpiStore, pg8::StaticOrder, true, true>(lds, g, S, E); }
        else {
            pg8::EpiInAC E{(bf16_t*)(big + B_Q), (bf16_t*)(big + B_K), (bf16_t*)(big + B_V), (bf16_t*)(big + B_SCRB), 768, 4, SSQ,
                           kind == 0 ? args.in[5] + jj * 64 : args.in[18], kind == 0 ? args.in[6] + jj * 64 : args.in[19]};
            if constexpr (kind == 0) {
                static_assert(IDX_OFF_SI == B_SCRB && IDX_OFF_QI == B_QI && IDX_OFF_KI == B_KI && IDX_OFF_WI == B_WI, "workspace map");
                IdxOrder SI_; SI_.so = S; SI_.big = big; SI_.kig = args.in[7] + jj * 64; SI_.ROPE = ROPE; SI_.first = 12;
                pg8::gemm_phase<pg8::EpiInAC, IdxOrder, true, true>(lds, g, SI_, E); }
            else pg8::gemm_phase<pg8::EpiInAC, pg8::StaticOrder, true, true>(lds, g, S, E); }
        if (kind != 2) {
            constexpr int extra = ((M_TOK / 256) * (N / 256)) % 256;
            if (G_ == 256 && (int)blockIdx.x >= extra) { __syncthreads();
                FfnConv fc{args.in[22] + (size_t)LAYER * D_MODEL * UPW, args.in[25] + (size_t)LAYER * D_FF * 1024, args.in[2] + (size_t)LAYER * D_MODEL, wreg + W_UP, wreg + W_DN, lds, ((int)blockIdx.x - extra) * NWAVES + c.wave, (256 - extra) * NWAVES, lane, c.wave, 0};
                fc(0); }
        }
      }
    }
    if (kind == 1 && RUN(2)) { SEAM();
      {
        {
            for (int m = gw; m < M_TOK; m += 8 * NGW) post_b1_rows<8>((const bf16_t*)(big + B_SCRB), m, NGW, args.in[10], args.in[11], (bf16_t*)(big + BB_CQN), (bf16_t*)(big + BB_CKVN), (float*)(big + BB_KR), lane); }
      }
    }
    if (kind == 1 && RUN(3)) { SEAM();
      {
        pg8::Gemm g{(const bf16_t*)(big + BB_CQN), (const bf16_t*)(wreg + W_UQ), M_TOK, 1536, 256 + args.pad}; pg8::StaticOrder S; S.init(M_TOK, 1536, G_, (int)blockIdx.x);
        pg8::EpiStore E{(bf16_t*)(big + BB_SCRQ), 1536, nullptr};
        pg8::gemm_phase<pg8::EpiStore, pg8::StaticOrder, true, true>(lds, g, S, E);
      }
    }
    if (kind == 1 && RUN(4)) { if (!RUN(3)) SEAM(); else __syncthreads();
      {
        pg8::Gemm g{(const bf16_t*)(big + BB_CKVN), (const bf16_t*)(wreg + W_UKV), M_TOK, 2048, 128 + args.pad};
        KOrder S; S.so.init(M_TOK, 2048, G_, (int)blockIdx.x); S.SKV = (const bf16_t*)(big + BB_SCRKV); S.KRB = (const float*)(big + BB_KR); S.kg = args.in[15]; S.ROPE = ROPE; S.KB = (bf16_t*)(big + BB_KB);
        pg8::EpiStore E{(bf16_t*)(big + BB_SCRKV), 2048, nullptr};
        pg8::gemm_phase<pg8::EpiStore, KOrder, true, true>(lds, g, S, E);
      }
    }
    if (kind == 0 && RUN(6)) { SEAM();
      {
        idx::idx_phase(lds, (const bf16_t*)(big + B_QI), (const bf16_t*)(big + B_KI), (const float*)(big + B_WI), (unsigned*)(big + B_MASK), vcu, G_);
      }
    }
    if (RUN(7)) { SEAM();
      {
        FfnConv pre{args.in[22] + (size_t)LAYER * D_MODEL * UPW, args.in[25] + (size_t)LAYER * D_FF * 1024, args.in[2] + (size_t)LAYER * D_MODEL, wreg + W_UP, wreg + W_DN, lds, gw, NGW, lane, c.wave, (kind == 2 || G_ != 256) ? (vcu & 3) : -1};
        if (kind == 0) att::attn_phase<64, 0>(lds, (const bf16_t*)(big + B_Q), (const bf16_t*)(big + B_K), (const bf16_t*)(big + B_V), (bf16_t*)(big + B_O), (const unsigned*)(big + B_MASK), args.in[3], args.in[5] + jj * 64, args.in[6] + jj * 64, vcu, G_, pre);
        else if (kind == 1) att::attn_phase<96, 1>(lds, (const bf16_t*)(big + BB_SCRQ), (const bf16_t*)(big + BB_KB), (const bf16_t*)(big + BB_SCRKV) + 64, (bf16_t*)(big + BB_O), nullptr, ROPE, args.in[14], args.in[15], vcu, G_, pre);
        else att::attn_phase<64, 2>(lds, (const bf16_t*)(big + B_Q), (const bf16_t*)(big + B_K), (const bf16_t*)(big + B_V), (bf16_t*)(big + B_O), nullptr, args.in[20], args.in[18], args.in[19], vcu, G_, pre);
      }
    }
    if (RUN(8)) { SEAM();
        pg8::Gemm g{(const bf16_t*)(big + (kind == 1 ? BB_O : B_O)), (const bf16_t*)(wreg + W_OUT), M_TOK, 1024, 1024}; pg8::StaticOrder S; S.init(M_TOK, 1024, G_, (int)blockIdx.x);
        pg8::EpiResidB E{Hb, SSQ + (size_t)M_TOK * 16, nullptr, 1024, true};
        pg8::gemm_phase<pg8::EpiResidB, pg8::StaticOrder, true, true>(lds, g, S, E);
    }
    if (RUN(10)) { SEAM();
      {
        pg8::Gemm g{Hb, (const bf16_t*)(wreg + W_UP), M_TOK, UPW, 1024};
        ConvOrder S; S.so.init(M_TOK, UPW, G_, (int)blockIdx.x); S.U = (const bf16_t*)(big + B_U); S.cw = args.in[23] + (size_t)LAYER * 3 * UPW; S.cb = args.in[24] + (size_t)LAYER * UPW; S.ACT = (bf16_t*)(big + B_ACT); S.ppm = -1; S.ppn = 0;
        pg8::EpiStore E{(bf16_t*)(big + B_U), UPW, SSQ + (size_t)M_TOK * 16};
        pg8::gemm_phase<pg8::EpiStore, ConvOrder, true, true>(lds, g, S, E);
        S.flush();
        if (LAYER + 1 < DEPTH) {
            const int extra = (M_TOK / 256) * (UPW / 256) % G_;
            if (extra > 0 && (int)blockIdx.x >= extra) { __syncthreads();
                int iw_ = ((int)blockIdx.x - extra) * NWAVES + c.wave, lane_ = lane; asm volatile("" : "+v"(lane_)); asm volatile("" : "+s"(iw_));
                prep_mixer<(LAYER + 1 < DEPTH ? LAYER + 1 : 0)>(args, wreg, (LAS float*)(lds + c.wave * 16384), iw_, (G_ - extra) * NWAVES, lane_); }
        }
      }
    }
    if (RUN(12)) { SEAM();
        pg8::Gemm g{(const bf16_t*)(big + B_ACT), (const bf16_t*)(wreg + W_DN), M_TOK, 1024, D_FF};
        DownOrder S; S.so.init(M_TOK, 1024, G_, (int)blockIdx.x); S.U = (const bf16_t*)(big + B_U); S.cw = args.in[23] + (size_t)LAYER * 3 * UPW; S.cb = args.in[24] + (size_t)LAYER * UPW; S.ACT = (bf16_t*)(big + B_ACT);
        pg8::EpiResidB E{Hb, LAYER < DEPTH - 1 ? SSQ + (size_t)2 * M_TOK * 16 : nullptr, LAYER == DEPTH - 1 ? X : nullptr, 1024, LAYER < DEPTH - 1};
        pg8::gemm_phase<pg8::EpiResidB, DownOrder, true, true>(lds, g, S, E);
    }
#undef RUN
}
#undef SEAM

__global__ void __launch_bounds__(NTHR, 2) mega(Args args) {
    extern __shared__ __attribute__((aligned(16))) unsigned char lds_raw[];
    LAS unsigned char* lds = (LAS unsigned char*)lds_raw;
    volatile LAS unsigned* MISC = (volatile LAS unsigned*)(lds + MISC_OFF);
    const int tid = threadIdx.x;
    Ctx c; c.lds = lds; c.a = &args; c.ws = args.ws; c.lo = args.ph_lo; c.hi = args.ph_hi; c.lane = tid & 63; c.wave = __builtin_amdgcn_readfirstlane(tid >> 6);
    c.G = gridDim.x; { const int bx = blockIdx.x; c.vcu = (c.G % 8 == 0) ? (bx % 8) * (c.G / 8) + bx / 8 : bx; }
    c.gw = c.vcu * NWAVES + c.wave; c.NGW = c.G * NWAVES; c.first = true;
    for (int u = tid; u < (LDS_BYTES - LDSCTL_OFF) / 4; u += NTHR) ((LAS unsigned*)(lds + LDSCTL_OFF))[u] = 0u;
    __syncthreads();
    const XcdBarrier bar = xcd_barrier_post((unsigned*)(args.ws + WS_CTL) + CW_BAR + args.li * XCD_BAR_WORDS, MISC + 8);
    run_layer<0>(c, bar); run_layer<1>(c, bar); run_layer<2>(c, bar); run_layer<3>(c, bar);
}
extern "C" void kernel_launch(void* const* d_in, const int* in_sizes, int n_in, void* d_out, int out_size, void* d_ws, size_t ws_size, hipStream_t stream) {
    static int grid = 0;
    if (grid == 0) {
        if (n_in != 26 || out_size != M_TOK * D_MODEL || ws_size < WS_END) { fprintf(stderr, "kernel_launch: unexpected sizes: n_in %d out %d ws %zu (need %zu); nothing launched\n", n_in, out_size, ws_size, (size_t)WS_END); grid = -1; return; }
        int dev = 0, cus = 0, per_cu = 0;
        if (hipGetDevice(&dev) != hipSuccess || hipDeviceGetAttribute(&cus, hipDeviceAttributeMultiprocessorCount, dev) != hipSuccess) { grid = -1; return; }
        if (hipFuncSetAttribute((const void*)mega, hipFuncAttributeMaxDynamicSharedMemorySize, LDS_BYTES) != hipSuccess) { fprintf(stderr, "kernel_launch: hipFuncSetAttribute failed\n"); grid = -1; return; }
        if (hipOccupancyMaxActiveBlocksPerMultiprocessor(&per_cu, (const void*)mega, NTHR, LDS_BYTES) != hipSuccess || per_cu < 1) fprintf(stderr, "kernel_launch: occupancy query reports %d\n", per_cu);
        (void)hipGetLastError();
        grid = cus;
    }
    if (grid < 0) return;
    (void)hipMemsetAsync((char*)d_ws + WS_CTL, 0, CTL_ZERO_BYTES, stream);
    Args a{};
    for (int i = 0; i < 26; ++i) a.in[i] = (const float*)d_in[i];
    a.out = (float*)d_out; a.ws = (unsigned char*)d_ws;
    a.ph_lo = 0; a.ph_hi = DEPTH * NPH; a.li = 0;
    hipLaunchKernelGGL(mega, dim3(grid), dim3(NTHR), LDS_BYTES, stream, a);
}
```
